# Optimizing an MI355X kernel written in HIP

```python
import jax, jax.numpy as jnp
from jax import lax
import numpy as np

D_MODEL = 1024
BATCH = 16
SEQ = 256
DEPTH = 2
DEC_BATCH = 4
DEC_SEQ = 4096
PAST_LEN = 512

GRID_W = 64
SC_DIM = 256
SC_WIDTH = 3
N_Q_HEADS = 8
N_KV_HEADS = 2
N_GROUP = N_Q_HEADS // N_KV_HEADS
HEAD_DIM = 64
ATT_DIM = N_Q_HEADS * HEAD_DIM
KV_DIM = N_KV_HEADS * HEAD_DIM
WINDOW = 128
BLOCK = 128
N_DN_HEADS = 4
DN_HEAD_DIM = 64
DN_DIM = N_DN_HEADS * DN_HEAD_DIM
DN_CONV = 3
CHUNK = 64
MIX_DIM = SC_DIM + ATT_DIM + DN_DIM
IN_SIZES = (SC_DIM, SC_DIM, SC_DIM, ATT_DIM, KV_DIM, KV_DIM, 3 * DN_DIM, DN_DIM, 2 * N_DN_HEADS, 2 * N_DN_HEADS)
IN_DIM = sum(IN_SIZES)
D_FF = -(-8 * D_MODEL // (3 * 256)) * 256
ROPE_BASE = 10000.0
EPS = 1e-6
NEG = -1e30

kernel_name = 'hybrid_diffusion_trunk_step'

F32 = jnp.float32


def _rms(x, g):
    xf = x.astype(F32)
    y = xf * lax.rsqrt(jnp.mean(xf * xf, axis=-1, keepdims=True) + EPS)
    return (y * g.astype(F32)).astype(x.dtype)


def _l2n(x):
    xf = x.astype(F32)
    return xf * lax.rsqrt(jnp.sum(xf * xf, axis=-1, keepdims=True) + EPS)


def _dwconv(x, w):
    p = w.shape[0] // 2
    return lax.conv_general_dilated(x, w[:, None, :].astype(x.dtype), (1,), [(p, p)],
                                    dimension_numbers=('NWC', 'WIO', 'NWC'),
                                    feature_group_count=x.shape[-1])


def _rope_part(x, pos):
    h = x.shape[-1] // 2
    inv = 1.0 / (ROPE_BASE ** (jnp.arange(h, dtype=F32) / h))
    ang = pos.astype(F32)[:, None] * inv
    cos = jnp.cos(ang)[None, :, None, :]
    sin = jnp.sin(ang)[None, :, None, :]
    x1, x2 = x[..., :h], x[..., h:]
    return jnp.concatenate([x1 * cos - x2 * sin, x2 * cos + x1 * sin], axis=-1)


def _axial_rope(x):
    n = x.shape[1]
    n_rows = n // GRID_W
    row = jnp.repeat(jnp.arange(n_rows), GRID_W)
    col = jnp.tile(jnp.arange(GRID_W), n_rows)
    xf = x.astype(F32)
    half = HEAD_DIM // 2
    out = jnp.concatenate([_rope_part(xf[..., :half], row), _rope_part(xf[..., half:], col)], axis=-1)
    return out.astype(x.dtype)


def _sink_attend(qb, sink, kv_sets):
    scale = HEAD_DIM ** -0.5
    logits = []
    for k, v, m in kv_sets:
        s = jnp.einsum('bqkgd,bskd->bkgqs', qb, k).astype(F32) * scale
        if m is not None:
            s = jnp.where(m, s, NEG)
        logits.append(s)
    bsz, nq = qb.shape[0], qb.shape[1]
    sink_l = jnp.broadcast_to(sink.astype(F32).reshape(N_KV_HEADS, N_GROUP)[None, :, :, None, None],
                              (bsz, N_KV_HEADS, N_GROUP, nq, 1))
    p = jax.nn.softmax(jnp.concatenate([sink_l] + logits, axis=-1), axis=-1)
    out = None
    off = 1
    for (k, v, m), s in zip(kv_sets, logits):
        ns = s.shape[-1]
        o = jnp.einsum('bkgqs,bskd->bqkgd', p[..., off:off + ns].astype(v.dtype), v)
        out = o if out is None else out + o
        off += ns
    return out


def _context_attention(q, k, v, sink):
    bsz, n = q.shape[0], q.shape[1]
    def blk(i):
        qb = lax.dynamic_slice_in_dim(q, i * BLOCK, BLOCK, axis=1)
        return _sink_attend(qb, sink, [(k, v, None)])
    o = lax.map(blk, jnp.arange(n // BLOCK))
    return jnp.moveaxis(o, 0, 1).reshape(bsz, n, ATT_DIM)


def _latent_attention(q, k, v, k_ctx, v_ctx, sink):
    bsz, n = q.shape[0], q.shape[1]
    pad = ((0, 0), (BLOCK, BLOCK), (0, 0), (0, 0))
    kp = jnp.pad(k, pad)
    vp = jnp.pad(v, pad)
    qoff = jnp.arange(BLOCK)
    koff = jnp.arange(3 * BLOCK) - BLOCK
    def blk(i):
        start = i * BLOCK
        qb = lax.dynamic_slice_in_dim(q, start, BLOCK, axis=1)
        kb = lax.dynamic_slice_in_dim(kp, start, 3 * BLOCK, axis=1)
        vb = lax.dynamic_slice_in_dim(vp, start, 3 * BLOCK, axis=1)
        qpos = start + qoff
        kpos = start + koff
        m = (jnp.abs(qpos[:, None] - kpos[None, :]) <= WINDOW) & (kpos >= 0)[None, :] & (kpos < n)[None, :]
        return _sink_attend(qb, sink, [(k_ctx, v_ctx, None), (kb, vb, m)])
    o = lax.map(blk, jnp.arange(n // BLOCK))
    return jnp.moveaxis(o, 0, 1).reshape(bsz, n, ATT_DIM)


def _gated_delta_chunked(q, k, v, g, beta, s0):
    b, n, h, dk = q.shape
    dv = v.shape[-1]
    nc = n // CHUNK
    def chunks(t):
        return jnp.swapaxes(t, 1, 2).reshape((b, h, nc, CHUNK) + t.shape[3:])
    qc, kc, vc, gc, bc = (chunks(t) for t in (q, k, v, g, beta))
    gc = jnp.cumsum(gc, axis=-1)
    idx = jnp.arange(CHUNK)
    incl = idx[:, None] >= idx[None, :]
    strict = idx[:, None] > idx[None, :]
    dec_incl = jnp.exp(jnp.where(incl, gc[..., :, None] - gc[..., None, :], NEG))
    dec_strict = jnp.where(strict, dec_incl, 0.0)
    kb = kc * bc[..., None]
    lmat = jnp.einsum('bhnid,bhnjd->bhnij', kb, kc) * dec_strict
    eye = jnp.eye(CHUNK, dtype=F32)
    rhs = jnp.concatenate([vc * bc[..., None], kb * jnp.exp(gc)[..., None]], axis=-1)
    sol = lax.linalg.triangular_solve(lmat + eye, rhs, left_side=True, lower=True, unit_diagonal=True)
    u, w = sol[..., :dv], sol[..., dv:]
    a_in = jnp.einsum('bhnid,bhnjd->bhnij', qc, kc) * dec_incl
    def step(s, inp):
        q_t, k_t, u_t, w_t, g_t, a_t = inp
        v_new = u_t - jnp.einsum('bhck,bhkv->bhcv', w_t, s)
        o = (jnp.einsum('bhck,bhkv->bhcv', q_t * jnp.exp(g_t)[..., None], s)
             + jnp.einsum('bhij,bhjv->bhiv', a_t, v_new))
        g_last = g_t[..., -1]
        s = (s * jnp.exp(g_last)[..., None, None]
             + jnp.einsum('bhck,bhcv->bhkv', k_t * jnp.exp(g_last[..., None] - g_t)[..., None], v_new))
        return s, o
    xs = tuple(jnp.moveaxis(t, 2, 0) for t in (qc, kc, u, w, gc, a_in))
    s_fin, o = lax.scan(step, s0, xs)
    o = jnp.swapaxes(jnp.moveaxis(o, 0, 2).reshape(b, h, n, dv), 1, 2)
    return o, s_fin


def _delta_mixer(qkv_in, z, a, bg, conv_w, a_log, dt_bias, norm_g, s0):
    bsz, n, _ = qkv_in.shape
    qkv = jax.nn.silu(_dwconv(qkv_in, conv_w))
    q, k, v = jnp.split(qkv, 3, axis=-1)
    shp = (bsz, n, N_DN_HEADS, DN_HEAD_DIM)
    q = _l2n(q.reshape(shp)) * (DN_HEAD_DIM ** -0.5)
    k = _l2n(k.reshape(shp))
    v = v.reshape(shp).astype(F32)
    a = a.reshape(bsz, n, 2, N_DN_HEADS).astype(F32)
    bg = bg.reshape(bsz, n, 2, N_DN_HEADS).astype(F32)
    gdec = -jnp.exp(a_log.astype(F32)) * jax.nn.softplus(a + dt_bias.astype(F32))
    beta = jax.nn.sigmoid(bg)
    s0 = s0.astype(F32)
    o_f, s_f = _gated_delta_chunked(q, k, v, gdec[:, :, 0], beta[:, :, 0], s0[:, 0])
    fl = lambda t: jnp.flip(t, axis=1)
    o_b, s_b = _gated_delta_chunked(fl(q), fl(k), fl(v), fl(gdec[:, :, 1]), fl(beta[:, :, 1]), s0[:, 1])
    o = o_f + fl(o_b)
    o = _rms(o, norm_g) * jax.nn.silu(z.reshape(shp).astype(F32))
    return o.reshape(bsz, n, DN_DIM).astype(z.dtype), jnp.stack([s_f, s_b], axis=1)


def _layer(x, cvec, p, ctx):
    bsz, n, _ = x.shape
    mod = (jax.nn.silu(cvec) @ p['ada_w'] + p['ada_b'])[:, None, :]
    sh1, sc1, g1, sh2, sc2, g2 = jnp.split(mod, 6, axis=-1)
    h = _rms(x, p['norm1_g']) * (1 + sc1) + sh1
    splits = np.cumsum(IN_SIZES)[:-1].tolist()
    sc_b, sc_c, sc_h, q, k, v, dn_qkv, dn_z, dn_a, dn_b = jnp.split(h @ p['w_in'], splits, axis=-1)
    y_sc = sc_b * _dwconv(sc_c * sc_h, p['sc_conv_w'])
    q = _rms(q.reshape(bsz, n, N_Q_HEADS, HEAD_DIM), p['q_norm_g'])
    k = _rms(k.reshape(bsz, n, N_KV_HEADS, HEAD_DIM), p['k_norm_g'])
    v = v.reshape(bsz, n, N_KV_HEADS, HEAD_DIM)
    gshape = (bsz, n, N_KV_HEADS, N_GROUP, HEAD_DIM)
    if ctx is None:
        y_att = _context_attention(q.reshape(gshape), k, v, p['attn_sink'])
        s0 = jnp.zeros((bsz, 2, N_DN_HEADS, DN_HEAD_DIM, DN_HEAD_DIM), F32)
    else:
        k_ctx, v_ctx, s0 = ctx
        y_att = _latent_attention(_axial_rope(q).reshape(gshape), _axial_rope(k), v,
                                  k_ctx.astype(k.dtype), v_ctx.astype(v.dtype), p['attn_sink'])
    y_dn, s_out = _delta_mixer(dn_qkv, dn_z, dn_a, dn_b, p['dn_conv_w'], p['dn_A_log'],
                               p['dn_dt_bias'], p['dn_norm_g'], s0)
    y = jnp.concatenate([y_sc, y_att.astype(y_sc.dtype), y_dn], axis=-1) @ p['w_out']
    x = x + g1 * y
    h2 = _rms(x, p['norm2_g']) * (1 + sc2) + sh2
    x = x + g2 * ((jax.nn.silu(h2 @ p['w_gate']) * (h2 @ p['w_up'])) @ p['w_down'])
    if ctx is None:
        return x, (k, v, s_out.astype(x.dtype))
    return x, None


def setup_inputs(seed: int = 0) -> dict:
    key = jax.random.key(seed)
    ks = jax.random.split(key, 32)
    nrm = lambda i, shape, s: jax.random.normal(ks[i], shape, F32) * s
    a_raw = jax.random.uniform(ks[20], (DEPTH, 2, N_DN_HEADS), F32, 1.0, 16.0)
    dt = jnp.exp(jax.random.uniform(ks[21], (DEPTH, 2, N_DN_HEADS), F32, float(np.log(1e-3)), float(np.log(1e-1))))
    return {
        'x_prompt': nrm(0, (BATCH, SEQ, D_MODEL), 1.0),
        'x_sample': nrm(1, (DEC_BATCH, DEC_SEQ, D_MODEL), 1.0),
        'cache_k': nrm(2, (DEC_BATCH, DEPTH, PAST_LEN, N_KV_HEADS, HEAD_DIM), 1.0),
        'cache_v': nrm(3, (DEC_BATCH, DEPTH, PAST_LEN, N_KV_HEADS, HEAD_DIM), 1.0),
        'state_delta': nrm(4, (DEC_BATCH, DEPTH, 2, N_DN_HEADS, DN_HEAD_DIM, DN_HEAD_DIM), 0.1),
        'c': nrm(5, (DEC_BATCH, D_MODEL), 1.0),
        'c_ctx': nrm(6, (D_MODEL,), 1.0),
        'w_in': nrm(7, (DEPTH, D_MODEL, IN_DIM), D_MODEL ** -0.5),
        'w_out': nrm(8, (DEPTH, MIX_DIM, D_MODEL), MIX_DIM ** -0.5),
        'ada_w': nrm(9, (DEPTH, D_MODEL, 6 * D_MODEL), 0.5 * D_MODEL ** -0.5),
        'ada_b': nrm(10, (DEPTH, 6 * D_MODEL), 0.01),
        'norm1_g': 1.0 + nrm(11, (DEPTH, D_MODEL), 0.05),
        'norm2_g': 1.0 + nrm(12, (DEPTH, D_MODEL), 0.05),
        'sc_conv_w': nrm(13, (DEPTH, SC_WIDTH, SC_DIM), SC_WIDTH ** -0.5),
        'dn_conv_w': nrm(14, (DEPTH, DN_CONV, 3 * DN_DIM), DN_CONV ** -0.5),
        'q_norm_g': 1.0 + nrm(15, (DEPTH, HEAD_DIM), 0.05),
        'k_norm_g': 1.0 + nrm(16, (DEPTH, HEAD_DIM), 0.05),
        'attn_sink': nrm(17, (DEPTH, N_Q_HEADS), 0.5),
        'dn_A_log': jnp.log(a_raw),
        'dn_dt_bias': dt + jnp.log(-jnp.expm1(-dt)),
        'dn_norm_g': 1.0 + nrm(18, (DEPTH, DN_HEAD_DIM), 0.05),
        'w_gate': nrm(22, (DEPTH, D_MODEL, D_FF), D_MODEL ** -0.5),
        'w_up': nrm(23, (DEPTH, D_MODEL, D_FF), D_MODEL ** -0.5),
        'w_down': nrm(24, (DEPTH, D_FF, D_MODEL), D_FF ** -0.5),
    }


def reference(x_prompt, x_sample, cache_k, cache_v, state_delta, c, c_ctx, w_in, w_out, ada_w, ada_b,
              norm1_g, norm2_g, sc_conv_w, dn_conv_w, q_norm_g, k_norm_g, attn_sink, dn_A_log,
              dn_dt_bias, dn_norm_g, w_gate, w_up, w_down):
    xp, xs = x_prompt, x_sample
    new_k, new_v, new_s = [], [], []
    for l in range(DEPTH):
        p = {'w_in': w_in[l], 'w_out': w_out[l], 'ada_w': ada_w[l], 'ada_b': ada_b[l],
             'norm1_g': norm1_g[l], 'norm2_g': norm2_g[l], 'sc_conv_w': sc_conv_w[l],
             'dn_conv_w': dn_conv_w[l], 'q_norm_g': q_norm_g[l], 'k_norm_g': k_norm_g[l],
             'attn_sink': attn_sink[l], 'dn_A_log': dn_A_log[l], 'dn_dt_bias': dn_dt_bias[l],
             'dn_norm_g': dn_norm_g[l], 'w_gate': w_gate[l], 'w_up': w_up[l], 'w_down': w_down[l]}
        xp, (kl, vl, sl) = _layer(xp, c_ctx[None, :], p, None)
        new_k.append(kl)
        new_v.append(vl)
        new_s.append(sl)
        xs, _ = _layer(xs, c, p, (cache_k[:, l], cache_v[:, l], state_delta[:, l]))
    return (xp, xs, jnp.stack(new_k, axis=1), jnp.stack(new_v, axis=1), jnp.stack(new_s, axis=1))
```

```cpp
#include <hip/hip_runtime.h>

#include <hip/hip_cooperative_groups.h>
#include <cstdio>
#include <cstdint>
namespace cg = cooperative_groups;

#define LAS __attribute__((address_space(3)))
typedef unsigned short bf16_t;
typedef short bf16x8 __attribute__((ext_vector_type(8)));
typedef float f32x4 __attribute__((ext_vector_type(4)));
typedef unsigned u32x4 __attribute__((ext_vector_type(4)));
typedef unsigned u32x2 __attribute__((ext_vector_type(2)));
typedef short v4i16_t __attribute__((ext_vector_type(4)));
typedef short bf16x4_t __attribute__((ext_vector_type(4)));

constexpr int D = 1024, NTOK = 20480, NPT = 4096, INW = 2576, INP = 2816, FF = 2816, FF2 = 5632;
constexpr float EPS = 1e-6f;
constexpr float LOG2E = 1.4426950408889634f;
constexpr size_t OUT_K = 20971520, OUT_V = 22020096, OUT_S = 23068672;
constexpr size_t WS_WIN = 0;
constexpr size_t WS_ABUF = 11534336;
constexpr size_t WS_PROJ = WS_ABUF + 41943040;
constexpr size_t WS_DN = WS_PROJ + 115343360;
constexpr size_t DN_MAT = 2560ull * 8192ull;
constexpr size_t WS_WOUT = WS_DN, WS_WGU = WS_DN + 2097152, WS_WDN = WS_WGU + 11534336;
constexpr size_t WS_OFB = WS_DN + 3 * DN_MAT;
constexpr size_t WS_MOD = WS_OFB + 20971520;
constexpr size_t WS_DNG = WS_MOD + 245760;
constexpr size_t WS_BAR = WS_DNG + 10240;
constexpr size_t WS_CK = WS_BAR + 16384;
constexpr size_t WS_CV = WS_CK + 524288;
constexpr size_t WS_END = WS_CV + 524288;
constexpr int LDS_BYTES = 147456;
constexpr int PTAB_OFF = LDS_BYTES - 256;

struct Params {
    const float* in[24];
    float* out; unsigned char* ws;
    int ph_lo, ph_hi;
};

__device__ __forceinline__ unsigned f2bf(float f) { unsigned u = __float_as_uint(f); return (u + 0x7fffu + ((u >> 16) & 1u)) >> 16; }
__device__ __forceinline__ unsigned pk2(float lo, float hi) { typedef float f32x2_t __attribute__((ext_vector_type(2))); typedef __bf16 bf16x2_t __attribute__((ext_vector_type(2))); f32x2_t v = {lo, hi}; return __builtin_bit_cast(unsigned, __builtin_convertvector(v, bf16x2_t)); }
__device__ __forceinline__ float bf_lo(unsigned u) { return __uint_as_float(u << 16); }
__device__ __forceinline__ float bf_hi(unsigned u) { return __uint_as_float(u & 0xffff0000u); }
__device__ __forceinline__ float bf2f(bf16_t b) { return __uint_as_float(((unsigned)b) << 16); }
__device__ __forceinline__ void unpack8(u32x4 r, float* x) {
    x[0] = bf_lo(r.x); x[1] = bf_hi(r.x); x[2] = bf_lo(r.y); x[3] = bf_hi(r.y); x[4] = bf_lo(r.z); x[5] = bf_hi(r.z); x[6] = bf_lo(r.w); x[7] = bf_hi(r.w);
}
__device__ __forceinline__ u32x4 pack8(const float* x) { u32x4 r; r.x = pk2(x[0], x[1]); r.y = pk2(x[2], x[3]); r.z = pk2(x[4], x[5]); r.w = pk2(x[6], x[7]); return r; }
__device__ __forceinline__ float siluf(float x) { return x * __builtin_amdgcn_rcpf(1.f + __expf(-x)); }
__device__ __forceinline__ int mi_of(int row) { return row < NPT ? 0 : 1 + ((row - NPT) >> 12); }
__device__ __forceinline__ f32x4 mfma16(bf16x8 a, bf16x8 b, f32x4 c) { return __builtin_amdgcn_mfma_f32_16x16x32_bf16(a, b, c, 0, 0, 0); }
__device__ __forceinline__ bf16x8 as_bf8(u32x4 v) { return __builtin_bit_cast(bf16x8, v); }

__device__ __forceinline__ float shx(float v, int m, int lane) { return __int_as_float(__builtin_amdgcn_ds_bpermute((lane ^ m) << 2, __float_as_int(v))); }
__device__ __forceinline__ float shl_(float v, int src, int  ) { return __int_as_float(__builtin_amdgcn_ds_bpermute(src << 2, __float_as_int(v))); }
__device__ __forceinline__ void lds_barrier() { asm volatile("s_waitcnt lgkmcnt(0)" ::: "memory"); __builtin_amdgcn_s_barrier(); asm volatile("" ::: "memory"); }
__device__ __forceinline__ unsigned long long uni64(unsigned long long v) { const unsigned lo = __builtin_amdgcn_readfirstlane((unsigned)v), hi = __builtin_amdgcn_readfirstlane((unsigned)(v >> 32)); return ((unsigned long long)hi << 32) | lo; }
namespace pg8 {
constexpr int BM = 256, BK = 64, HALF = 128, HTB = HALF * BK * 2, STAGE_BYTES = 8 * HTB, NXCD = 8, WGM = 8;
__host__ __device__ __forceinline__ int lds_byte(int r, int c) { const int st = (r >> 4) * 2 + (c >> 5), rr = r & 15, cc = c & 31, ob = rr * 64 + cc * 2; return st * 1024 + (ob ^ (((ob >> 9) & 1) << 5)); }
__host__ __device__ __forceinline__ void stage_rc(int b, int& R, int& C) { const int st = b / 1024, sb = b % 1024, swz = sb ^ (((sb >> 9) & 1) << 5); R = (st >> 1) * 16 + swz / 64; C = (st & 1) * 32 + (swz % 64) / 2; }
__host__ __device__ __forceinline__ int perm32(int rho) { const int n = rho >> 4, i = rho & 15; return 8 * (i >> 2) + 4 * n + (i & 3); }
struct Unit { int pm, pn; };
struct Gemm { const bf16_t* A; const bf16_t* Bt; int M, N, K; };
struct StaticOrder {
    int nM, nN, nwg, G, c;
    __device__ void init(int M, int N, int G_, int c_) { nM = M / BM; nN = N / BM; nwg = nM * nN; G = G_; c = c_; }
    __device__ bool next(int i, Unit& u) const {
        const long L = (long)i * G + c; if (L >= nwg) return false;
        int wgid = (int)L; { const int q = nwg / NXCD, r = nwg % NXCD, xcd = wgid % NXCD, off = wgid / NXCD; wgid = (xcd < r ? xcd * (q + 1) : r * (q + 1) + (xcd - r) * q) + off; }
        const int nig = WGM * nN, gid = wgid / nig, fm = gid * WGM, gsz = (nM - fm) < WGM ? (nM - fm) : WGM;
        u.pm = fm + ((wgid % nig) % gsz); u.pn = (wgid % nig) / gsz; return true;
    }
};
__device__ __forceinline__ unsigned cvt_pk_bf16(float lo, float hi) { unsigned r; asm volatile("v_cvt_pk_bf16_f32 %0, %1, %2" : "=v"(r) : "v"(lo), "v"(hi)); return r; }

template <class Epi, class Sched, bool ALIGN_EPI = false, bool SP2 = false>
__device__ __forceinline__ void gemm_phase(LAS unsigned char* lds, const Gemm g, const Sched& S, const Epi& E, int tid_) {
    const int tid = tid_, wid = __builtin_amdgcn_readfirstlane(tid >> 6), lane = tid & 63, wr = wid >> 2, wc = wid & 3, fr = lane & 15, fq = lane >> 4;
    const int K = g.K, nt = K / BK;
    unsigned voffA[2], voffB[2];
#pragma unroll
    for (int i = 0; i < 2; ++i) { int R, C; stage_rc(tid * 16 + i * 8192, R, C); const int Rb = E.perm ? ((R & ~31) + perm32(R & 31)) : R;
        voffA[i] = (unsigned)(R * K + C) * 2u; voffB[i] = (unsigned)(Rb * K + C) * 2u; }
    const size_t kstep = (size_t)(BK * 2);
    const size_t hstep = (size_t)HALF * K * 2;
    const size_t tstep = 2 * hstep;
    const unsigned ldsw = (unsigned)wid * 1024u;
    const int aoff = lds_byte(wr * 64 + fr, fq * 8), boff = lds_byte(wc * 32 + fr, fq * 8);
#define PG8_SA(b, h) (((b) * 2 + (h)) * HTB)
#define PG8_SB(b, h) ((4 + (b) * 2 + (h)) * HTB)
#define PG8_STAGE(bufoff, gbase, voff) do { _Pragma("unroll") for (int _i = 0; _i < 2; ++_i) \
        __builtin_amdgcn_global_load_lds((const unsigned*)((const char*)(gbase) + (voff)[_i]), (LAS unsigned*)(lds + (bufoff) + ldsw + _i * 8192), 16, 0, 0); } while (0)
#define PG8_LDA(dst, b, h) do { _Pragma("unroll") for (int m = 0; m < 4; ++m) _Pragma("unroll") for (int k = 0; k < 2; ++k) dst[m][k] = *(const LAS bf16x8*)(lds + PG8_SA(b, h) + aoff + m * 2048 + k * 1024); } while (0)
#define PG8_LDB(dst, b, h) do { _Pragma("unroll") for (int n = 0; n < 2; ++n) _Pragma("unroll") for (int k = 0; k < 2; ++k) dst[n][k] = *(const LAS bf16x8*)(lds + PG8_SB(b, h) + boff + n * 2048 + k * 1024); } while (0)
#define PG8_MMA(ai, bj, At, Bt) do { __builtin_amdgcn_s_setprio(1); _Pragma("unroll") for (int m = 0; m < 4; ++m) _Pragma("unroll") for (int n = 0; n < 2; ++n) _Pragma("unroll") for (int k = 0; k < 2; ++k) \
        acc[ai][bj][m][n] = __builtin_amdgcn_mfma_f32_16x16x32_bf16(Bt[n][k], At[m][k], acc[ai][bj][m][n], 0, 0, 0); __builtin_amdgcn_s_setprio(0); } while (0)
#define PG8_WAIT_V(n) asm volatile("s_waitcnt vmcnt(" #n ")" ::: "memory")
#define PG8_WAIT_L(n) asm volatile("s_waitcnt lgkmcnt(" #n ")" ::: "memory")
#define PG8_BAR __builtin_amdgcn_s_barrier()
#define PG8_SCHED __builtin_amdgcn_sched_barrier(0)
    Unit cur, nxt; int ui = 0;
    if (!S.next(0, cur)) return;
    f32x4 acc[2][2][4][2];
#pragma unroll
    for (int a = 0; a < 2; ++a)
#pragma unroll
        for (int b = 0; b < 2; ++b)
#pragma unroll
            for (int m = 0; m < 4; ++m)
#pragma unroll
                for (int n = 0; n < 2; ++n) acc[a][b][m][n] = (f32x4){0.f, 0.f, 0.f, 0.f};
    bf16x8 At[4][2], B0[2][2], B1[2][2];
    const char* cA = (const char*)g.A + (size_t)cur.pm * tstep; const char* cB = (const char*)g.Bt + (size_t)cur.pn * tstep;
    if constexpr (SP2) {
        PG8_STAGE(PG8_SB(0, 0), cB, voffB); PG8_STAGE(PG8_SB(0, 1), cB + hstep, voffB); PG8_STAGE(PG8_SA(0, 0), cA, voffA); PG8_STAGE(PG8_SA(0, 1), cA + hstep, voffA);
        if (wr == 1) PG8_BAR;
        PG8_WAIT_V(2); PG8_BAR;
        PG8_STAGE(PG8_SB(1, 0), cB + kstep, voffB); PG8_STAGE(PG8_SA(1, 0), cA + kstep, voffA); PG8_STAGE(PG8_SB(1, 1), cB + hstep + kstep, voffB);
        PG8_WAIT_V(6); PG8_BAR;
    } else {
        PG8_STAGE(PG8_SB(0, 0), cB, voffB); PG8_STAGE(PG8_SA(0, 0), cA, voffA); PG8_STAGE(PG8_SB(0, 1), cB + hstep, voffB); PG8_STAGE(PG8_SA(0, 1), cA + hstep, voffA);
        if (wr == 1) PG8_BAR;
        PG8_WAIT_V(4); PG8_BAR;
        PG8_STAGE(PG8_SB(1, 0), cB + kstep, voffB); PG8_STAGE(PG8_SA(1, 0), cA + kstep, voffA); PG8_STAGE(PG8_SB(1, 1), cB + hstep + kstep, voffB);
        PG8_WAIT_V(6); PG8_BAR;
    }
    for (;;) {
        const bool has_next = S.next(ui + 1, nxt);
        const char* nA = has_next ? (const char*)g.A + (size_t)nxt.pm * tstep : cA; const char* nB = has_next ? (const char*)g.Bt + (size_t)nxt.pn * tstep : cB;
        for (int t = 0; t < nt; t += 2) {
            const bool last = (t == nt - 2);
            const char* a1 = cA + (size_t)(t + 1) * kstep;
            const char* a2 = last ? nA : cA + (size_t)(t + 2) * kstep; const char* b2 = last ? nB : cB + (size_t)(t + 2) * kstep;
            const char* a3 = a2 + kstep; const char* b3 = b2 + kstep;
            if constexpr (SP2) {
            PG8_LDB(B0, 0, 0); PG8_LDB(B1, 0, 1); PG8_SCHED; PG8_LDA(At, 0, 0); PG8_STAGE(PG8_SA(1, 1), a1 + hstep, voffA);
            PG8_WAIT_V(8); PG8_WAIT_L(0); PG8_BAR; PG8_MMA(0, 0, At, B0); PG8_MMA(0, 1, At, B1); PG8_BAR; PG8_SCHED;
            PG8_LDA(At, 0, 1); PG8_STAGE(PG8_SB(0, 0), b2, voffB); PG8_STAGE(PG8_SB(0, 1), b2 + hstep, voffB); PG8_STAGE(PG8_SA(0, 0), a2, voffA);
            PG8_WAIT_V(8); PG8_WAIT_L(0); PG8_BAR; PG8_MMA(1, 0, At, B0); PG8_MMA(1, 1, At, B1); PG8_BAR; PG8_SCHED;
            PG8_LDB(B0, 1, 0); PG8_LDB(B1, 1, 1); PG8_SCHED; PG8_LDA(At, 1, 0); PG8_STAGE(PG8_SA(0, 1), a2 + hstep, voffA);
            PG8_WAIT_V(8); PG8_WAIT_L(0); PG8_BAR; PG8_MMA(0, 0, At, B0); PG8_MMA(0, 1, At, B1); PG8_BAR; PG8_SCHED;
            PG8_LDA(At, 1, 1); PG8_STAGE(PG8_SB(1, 0), b3, voffB); PG8_STAGE(PG8_SB(1, 1), b3 + hstep, voffB); PG8_STAGE(PG8_SA(1, 0), a3, voffA);
            PG8_WAIT_V(8); PG8_WAIT_L(0); PG8_BAR; PG8_MMA(1, 0, At, B0); PG8_MMA(1, 1, At, B1); PG8_BAR; PG8_SCHED;
            } else {
            PG8_LDB(B0, 0, 0); PG8_SCHED; PG8_LDA(At, 0, 0); PG8_STAGE(PG8_SA(1, 1), a1 + hstep, voffA);
            PG8_WAIT_L(8); PG8_BAR; PG8_WAIT_L(0); PG8_MMA(0, 0, At, B0); PG8_BAR; PG8_SCHED;
            PG8_LDB(B1, 0, 1); PG8_STAGE(PG8_SB(0, 0), b2, voffB);
            PG8_BAR; PG8_WAIT_L(0); PG8_MMA(0, 1, At, B1); PG8_BAR;
            PG8_LDA(At, 0, 1); PG8_STAGE(PG8_SA(0, 0), a2, voffA);
            PG8_BAR; PG8_WAIT_L(0); PG8_MMA(1, 0, At, B0); PG8_BAR; PG8_SCHED;
            PG8_STAGE(PG8_SB(0, 1), b2 + hstep, voffB);
            PG8_WAIT_V(6); PG8_BAR; PG8_MMA(1, 1, At, B1); PG8_BAR;
            PG8_LDB(B0, 1, 0); PG8_SCHED; PG8_LDA(At, 1, 0); PG8_STAGE(PG8_SA(0, 1), a2 + hstep, voffA);
            PG8_WAIT_L(8); PG8_BAR; PG8_WAIT_L(0); PG8_MMA(0, 0, At, B0); PG8_BAR; PG8_SCHED;
            PG8_LDB(B1, 1, 1); PG8_STAGE(PG8_SB(1, 0), b3, voffB);
            PG8_BAR; PG8_WAIT_L(0); PG8_MMA(0, 1, At, B1); PG8_BAR;
            PG8_LDA(At, 1, 1); PG8_STAGE(PG8_SA(1, 0), a3, voffA);
            PG8_BAR; PG8_WAIT_L(0); PG8_MMA(1, 0, At, B0); PG8_BAR; PG8_SCHED;
            PG8_STAGE(PG8_SB(1, 1), b3 + hstep, voffB);
            PG8_WAIT_V(6); PG8_BAR; PG8_MMA(1, 1, At, B1); PG8_BAR;
            }
        }
        if constexpr (ALIGN_EPI) { if (wr == 0) PG8_BAR; }
        E(acc, cur, wr, wc, fr, fq);
        if (!has_next) break;
#pragma unroll
        for (int a = 0; a < 2; ++a)
#pragma unroll
            for (int b = 0; b < 2; ++b)
#pragma unroll
                for (int m = 0; m < 4; ++m)
#pragma unroll
                    for (int n = 0; n < 2; ++n) acc[a][b][m][n] = (f32x4){0.f, 0.f, 0.f, 0.f};
        cur = nxt; cA = nA; cB = nB; ++ui;
        if constexpr (ALIGN_EPI) { if (wr == 1) PG8_BAR; }
    }
    PG8_WAIT_V(0);
    if constexpr (!ALIGN_EPI) { if (wr == 0) PG8_BAR; }
    PG8_BAR;
#undef PG8_SA
#undef PG8_SB
#undef PG8_STAGE
#undef PG8_LDA
#undef PG8_LDB
#undef PG8_MMA
#undef PG8_WAIT_V
#undef PG8_WAIT_L
#undef PG8_BAR
#undef PG8_SCHED
}
}

struct EpiAny {
    int mode; bool perm;
    bf16_t* O; const float* xa; const float* xb; const float* modl; int goff; float* out;
    __device__ __forceinline__ void operator()(const f32x4 (&acc)[2][2][4][2], const pg8::Unit& u, int wr, int wc, int fr, int fq) const {
        const int row0 = u.pm * 256 + wr * 64 + fr;
        if (mode == 0) {
            const int col0 = u.pn * 256 + wc * 32 + 8 * fq;
#pragma unroll
            for (int ai = 0; ai < 2; ++ai)
#pragma unroll
                for (int m = 0; m < 4; ++m) { bf16_t* rowp = O + (size_t)(row0 + ai * 128 + m * 16) * INW;
#pragma unroll
                    for (int bj = 0; bj < 2; ++bj) { const int col = col0 + bj * 128;
                        if (col < INW) { const f32x4 v0 = acc[ai][bj][m][0], v1 = acc[ai][bj][m][1]; u32x4 w;
                            w.x = pg8::cvt_pk_bf16(v0[0], v0[1]); w.y = pg8::cvt_pk_bf16(v0[2], v0[3]); w.z = pg8::cvt_pk_bf16(v1[0], v1[1]); w.w = pg8::cvt_pk_bf16(v1[2], v1[3]);
                            *(u32x4*)(rowp + col) = w; } } }
        } else if (mode == 1) {
            const int col0 = u.pn * 256 + wc * 32 + 4 * fq;
            const float* gp = modl + mi_of(u.pm * 256) * 6144 + goff;
#pragma unroll
            for (int ai = 0; ai < 2; ++ai)
#pragma unroll
                for (int m = 0; m < 4; ++m) { const int row = row0 + ai * 128 + m * 16;
                    const float* xs = row < NPT ? xa + (size_t)row * D : xb + (size_t)(row - NPT) * D; float* o = out + (size_t)row * D;
#pragma unroll
                    for (int bj = 0; bj < 2; ++bj)
#pragma unroll
                        for (int n = 0; n < 2; ++n) { const int col = col0 + bj * 128 + n * 16;
                            const f32x4 xv = *(const f32x4*)(xs + col), gv = *(const f32x4*)(gp + col);
                            *(f32x4*)(o + col) = xv + gv * acc[ai][bj][m][n]; } }
        } else {
#pragma unroll
            for (int ai = 0; ai < 2; ++ai)
#pragma unroll
                for (int m = 0; m < 4; ++m) { bf16_t* rowp = O + (size_t)(row0 + ai * 128 + m * 16) * FF;
                    const int oc = u.pn * 128 + wc * 32 + 8 * fq;
                    float a[8];
#pragma unroll
                    for (int n = 0; n < 2; ++n) { const f32x4 gt = acc[ai][0][m][n], up = acc[ai][1][m][n];
#pragma unroll
                        for (int k = 0; k < 4; ++k) a[4 * n + k] = gt[k] * __builtin_amdgcn_rcpf(1.f + __expf(-gt[k])) * up[k]; }
                    u32x4 w; w.x = pg8::cvt_pk_bf16(a[0], a[1]); w.y = pg8::cvt_pk_bf16(a[2], a[3]); w.z = pg8::cvt_pk_bf16(a[4], a[5]); w.w = pg8::cvt_pk_bf16(a[6], a[7]);
                    *(u32x4*)(rowp + oc) = w; }
        }
    }
};

template <int MODE>
__device__ __forceinline__ void transpose_item(const float* W, int K, int N, int nblk, bf16_t* WT, float* scr, int item, int lane) {
    const int kb = item / nblk, nb = item % nblk, k0 = 64 * kb, n0 = 32 * nb;
    const int nn = n0 + (lane & 31);
#pragma unroll
    for (int i = 0; i < 32; ++i) { const int kk = 2 * i + (lane >> 5); scr[kk * 33 + (lane & 31)] = (nn < N) ? W[(size_t)(k0 + kk) * N + nn] : 0.f; }
    __builtin_amdgcn_fence(__ATOMIC_RELEASE, "wavefront"); asm volatile("s_waitcnt lgkmcnt(0)" ::: "memory");
    const int c = lane & 7;
#pragma unroll
    for (int j = 0; j < 4; ++j) { const int n = (lane >> 3) + 8 * j; const float* s = scr + (8 * c) * 33 + n;
        u32x4 o; o.x = pk2(s[0 * 33], s[1 * 33]); o.y = pk2(s[2 * 33], s[3 * 33]); o.z = pk2(s[4 * 33], s[5 * 33]); o.w = pk2(s[6 * 33], s[7 * 33]);
        int row;
        if (MODE == 0) row = n0 + n; else row = 256 * (n0 >> 7) + (n0 & 127) + n + (MODE == 2 ? 128 : 0);
        *(u32x4*)(WT + (size_t)row * K + k0 + 8 * c) = o; }
    asm volatile("s_waitcnt lgkmcnt(0)" ::: "memory");
}

__device__ __forceinline__ void phase0(const Params& P, unsigned char* lds, int tid_, int bid_, int G_) {
    const int tid = tid_, lane = tid & 63, wave = tid >> 6, G = G_;
    float* sc = (float*)lds;
    float* red = (float*)(lds + 20480);
    float* modw = (float*)(P.ws + WS_MOD);
    if ((int)bid_ < 192) {
        for (int i = tid; i < 5 * 1024; i += 512) { const int mi = i >> 10, k = i & 1023; const float c = mi == 0 ? P.in[6][k] : P.in[5][(mi - 1) * 1024 + k]; sc[i] = c / (1.f + expf(-c)); }
        __syncthreads();
        for (int item = bid_; item < 192; item += G) {
            const int l = item / 96, cgp = item % 96, col = cgp * 64 + (tid & 15) * 4, kr = tid >> 4;
            const float* aw = P.in[9] + (size_t)l * 1024 * 6144;
            float acc[5][4];
#pragma unroll
            for (int mi = 0; mi < 5; ++mi)
#pragma unroll
                for (int j = 0; j < 4; ++j) acc[mi][j] = 0.f;
#pragma unroll 4
            for (int kk = kr; kk < 1024; kk += 32) { const f32x4 w = *(const f32x4*)(aw + (size_t)kk * 6144 + col);
#pragma unroll
                for (int mi = 0; mi < 5; ++mi) { const float s = sc[mi * 1024 + kk]; acc[mi][0] += s * w[0]; acc[mi][1] += s * w[1]; acc[mi][2] += s * w[2]; acc[mi][3] += s * w[3]; } }
#pragma unroll
            for (int mi = 0; mi < 5; ++mi)
#pragma unroll
                for (int j = 0; j < 4; ++j) red[(kr * 5 + mi) * 64 + (tid & 15) * 4 + j] = acc[mi][j];
            __syncthreads();
            if (tid < 320) { const int mi = tid >> 6, c = tid & 63; float s = 0.f;
                for (int r = 0; r < 32; ++r) s += red[(r * 5 + mi) * 64 + c];
                modw[((size_t)l * 5 + mi) * 6144 + cgp * 64 + c] = s + P.in[10][(size_t)l * 6144 + cgp * 64 + c]; }
            __syncthreads();
        }
    }
    __syncthreads();
    float* scr = (float*)(lds + 65536 + wave * 8448);
    const int gw = bid_ * 8 + wave, NGW = G * 8;
    constexpr int I_IN = 16 * 88;
    for (int it = gw; it < I_IN; it += NGW) { const int l = 0, r = it;
        transpose_item<0>(P.in[7] + (size_t)l * 1024 * INW, 1024, INW, 88, (bf16_t*)(P.ws + WS_WIN) + (size_t)l * INP * 1024, scr, r, lane); }
}

__device__ __forceinline__ void norm_phase(const float* xa, const float* xb, const float* g, const float* modl, int sh_off, int sc_off, bf16_t* H, int tid_, int bid_, int G_) {
    const int lane = tid_ & 63, wave = tid_ >> 6;
    const int gw = bid_ * 8 + wave, NGW = G_ * 8;
    auto ld = [&](int row, f32x4 (&v)[4]) { const float* x = row < NPT ? xa + (size_t)row * D : xb + (size_t)(row - NPT) * D;
#pragma unroll
        for (int j = 0; j < 4; ++j) v[j] = *(const f32x4*)(x + 4 * lane + 256 * j); };
    f32x4 v[4], v1[4], v2[4];
#pragma unroll
    for (int j = 0; j < 4; ++j) { v[j] = (f32x4){0.f, 0.f, 0.f, 0.f}; v1[j] = v[j]; v2[j] = v[j]; }
    if (gw < NTOK) ld(gw, v);
    if (gw + NGW < NTOK) ld(gw + NGW, v1);
    for (int row = gw; row < NTOK; row += NGW) {
        if (row + 2 * NGW < NTOK) ld(row + 2 * NGW, v2);
        const float* md = modl + mi_of(row) * 6144;
        float ss = 0.f;
#pragma unroll
        for (int j = 0; j < 4; ++j) ss += (v[j][0] * v[j][0] + v[j][1] * v[j][1]) + (v[j][2] * v[j][2] + v[j][3] * v[j][3]);
#pragma unroll
        for (int o = 1; o < 64; o <<= 1) ss += shx(ss, o, lane);
        const float rstd = rsqrtf(ss * (1.f / D) + EPS);
#pragma unroll
        for (int j = 0; j < 4; ++j) { const int col = 4 * lane + 256 * j;
            const f32x4 gg = *(const f32x4*)(g + col), scv = *(const f32x4*)(md + sc_off + col), shv = *(const f32x4*)(md + sh_off + col);
            f32x4 h = v[j] * rstd * gg * (scv + 1.f) + shv;
            u32x2 w; w.x = pk2(h[0], h[1]); w.y = pk2(h[2], h[3]);
            *(u32x2*)(H + (size_t)row * D + col) = w; }
#pragma unroll
        for (int j = 0; j < 4; ++j) { v[j] = v1[j]; v1[j] = v2[j]; }
    }
}

__device__ __forceinline__ void prep_rows(const Params& P, int l, unsigned char* lds, int tid_, int bid_, int G_) {
    const int tid = tid_, lane = tid & 63, wave = tid >> 6;
    float* tab = (float*)lds;
    for (int i = tid; i < 1024; i += 512) { const int pos = i >> 4, k = i & 15; const float inv = exp2f(-(float)k * (13.287712379549449f / 16.f)); float s, c; sincosf((float)pos * inv, &s, &c); tab[2 * i] = c; tab[2 * i + 1] = s; }
    __syncthreads();
    {
        bf16_t* ck = (bf16_t*)(P.ws + WS_CK); bf16_t* cv = (bf16_t*)(P.ws + WS_CV);
        for (int i = (bid_ * 512 + tid) * 8; i < 4 * 512 * 128; i += G_ * 512 * 8) { const int sq_ = i >> 16, rem = i & 65535;
            const size_t src_i = ((size_t)(sq_ * 2 + l) << 16) + rem;
            const f32x4 a = *(const f32x4*)(P.in[2] + src_i), b2 = *(const f32x4*)(P.in[2] + src_i + 4), c = *(const f32x4*)(P.in[3] + src_i), d = *(const f32x4*)(P.in[3] + src_i + 4);
            u32x4 w; w.x = pk2(a[0], a[1]); w.y = pk2(a[2], a[3]); w.z = pk2(b2[0], b2[1]); w.w = pk2(b2[2], b2[3]); *(u32x4*)(ck + i) = w;
            w.x = pk2(c[0], c[1]); w.y = pk2(c[2], c[3]); w.z = pk2(d[0], d[1]); w.w = pk2(d[2], d[3]); *(u32x4*)(cv + i) = w; }
    }
    bf16_t* PROJ = (bf16_t*)(P.ws + WS_PROJ); bf16_t* MIX = (bf16_t*)(P.ws + WS_ABUF);
    const float* qg = P.in[15] + l * 64; const float* kg = P.in[16] + l * 64; const float* cw = P.in[13] + (size_t)l * 3 * 256;
    const int gw = bid_ * 8 + wave, NGW = G_ * 8;
    struct PrepRaw { u32x4 q, k, v; u32x2 cc[3], hh[3], bb; };
    auto prep_load = [&](int row, PrepRaw& R) {
        const bool sample = row >= NPT; const int t = sample ? ((row - NPT) & 4095) : (row & 255); const int n = sample ? 4096 : 256;
        const bf16_t* pr = PROJ + (size_t)row * INW; const int c4 = lane * 4;
        R.q = *(const u32x4*)(pr + 768 + lane * 8);
        R.k = (u32x4){0u, 0u, 0u, 0u}; R.v = (u32x4){0u, 0u, 0u, 0u};
        if (lane < 16) { R.k = *(const u32x4*)(pr + 1280 + lane * 8); if (!sample) R.v = *(const u32x4*)(pr + 1408 + lane * 8); }
#pragma unroll
        for (int j = 0; j < 3; ++j) { const int tt = t + j - 1; R.cc[j] = (u32x2){0u, 0u}; R.hh[j] = (u32x2){0u, 0u};
            if (tt >= 0 && tt < n) { const bf16_t* q = pr + (ptrdiff_t)(j - 1) * INW; R.cc[j] = *(const u32x2*)(q + 256 + c4); R.hh[j] = *(const u32x2*)(q + 512 + c4); } }
        R.bb = *(const u32x2*)(pr + c4);
    };
    PrepRaw Rc, R1;
    if (gw < NTOK) prep_load(gw, Rc);
    R1 = Rc; if (gw + NGW < NTOK) prep_load(gw + NGW, R1);
    for (int row = gw; row < NTOK; row += NGW) {
        PrepRaw Rn = R1;
        if (row + 2 * NGW < NTOK) prep_load(row + 2 * NGW, Rn);
        const bool sample = row >= NPT; const int t = sample ? ((row - NPT) & 4095) : (row & 255);
        bf16_t* pr = PROJ + (size_t)row * INW;
        const int d0 = (lane & 7) * 8;
#pragma unroll
        for (int which = 0; which < 2; ++which) {
            const bool act = which == 0 || lane < 16;
            bf16_t* p = pr + (which == 0 ? 768 : 1280) + lane * 8;
            float x[8]; unpack8(which == 0 ? Rc.q : Rc.k, x);
            float ss = 0.f;
#pragma unroll
            for (int e = 0; e < 8; ++e) ss += x[e] * x[e];
            ss += shx(ss, 1, lane); ss += shx(ss, 2, lane); ss += shx(ss, 4, lane);
            const float rs = rsqrtf(ss * (1.f / 64.f) + EPS);
            const float* gp = which == 0 ? qg : kg;
#pragma unroll
            for (int e = 0; e < 8; ++e) x[e] = x[e] * rs * gp[d0 + e];
            if (which == 1 && !sample && act) { float* ok = P.out + OUT_K + ((size_t)((row >> 8) * 2 + l) * 256 + t) * 128 + lane * 8;
                *(f32x4*)ok = (f32x4){x[0], x[1], x[2], x[3]}; *(f32x4*)(ok + 4) = (f32x4){x[4], x[5], x[6], x[7]}; }
            if (sample) {
                const int half = d0 >> 5, part = (d0 >> 4) & 1, i0 = d0 & 15, pos = half ? (t & 63) : (t >> 6);
#pragma unroll
                for (int e = 0; e < 8; ++e) { const float pt = shx(x[e], 2, lane); const float c = tab[2 * (pos * 16 + i0 + e)], s = tab[2 * (pos * 16 + i0 + e) + 1];
                    x[e] = part == 0 ? x[e] * c - pt * s : x[e] * c + pt * s; }
            }
            if (which == 0) {
#pragma unroll
                for (int e = 0; e < 8; ++e) x[e] *= 0.125f * LOG2E;
            }
            if (act) *(u32x4*)p = pack8(x);
        }
        if (!sample && lane < 16) { float x[8]; unpack8(Rc.v, x);
            float* ov = P.out + OUT_V + ((size_t)((row >> 8) * 2 + l) * 256 + t) * 128 + lane * 8;
            *(f32x4*)ov = (f32x4){x[0], x[1], x[2], x[3]}; *(f32x4*)(ov + 4) = (f32x4){x[4], x[5], x[6], x[7]}; }
        {
            const int c4 = lane * 4; float acc[4] = {0.f, 0.f, 0.f, 0.f};
#pragma unroll
            for (int j = 0; j < 3; ++j) { const u32x2 cc = Rc.cc[j], hh = Rc.hh[j];
                const f32x4 w = *(const f32x4*)(cw + j * 256 + c4);
                acc[0] += w[0] * bf_lo(cc.x) * bf_lo(hh.x); acc[1] += w[1] * bf_hi(cc.x) * bf_hi(hh.x); acc[2] += w[2] * bf_lo(cc.y) * bf_lo(hh.y); acc[3] += w[3] * bf_hi(cc.y) * bf_hi(hh.y); }
            const u32x2 bb = Rc.bb;
            u32x2 w; w.x = pk2(acc[0] * bf_lo(bb.x), acc[1] * bf_hi(bb.x)); w.y = pk2(acc[2] * bf_lo(bb.y), acc[3] * bf_hi(bb.y));
            *(u32x2*)(MIX + (size_t)row * D + c4) = w;
        }
        Rc = R1; R1 = Rn;
    }
    __syncthreads();
}

template <int J> __device__ __forceinline__ void solve_cols(float (&x)[32], const float* lrow) {
    if constexpr (J < 63) {
        const float xj = __int_as_float(__builtin_amdgcn_update_dpp(0, __float_as_int(x[J >> 1]), (J & 1) ? 0xF5 : 0xA0, 0xf, 0xf, false));
        constexpr int R0 = ((J + 1) / 2) / 4;
#pragma unroll
        for (int r4 = R0; r4 < 8; ++r4) { const f32x4 Lv = *(const f32x4*)(lrow + J * 68 + 4 * r4);
            x[4 * r4 + 0] -= Lv[0] * xj; x[4 * r4 + 1] -= Lv[1] * xj; x[4 * r4 + 2] -= Lv[2] * xj; x[4 * r4 + 3] -= Lv[3] * xj; }
        asm volatile("" : "+v"(x[0]), "+v"(x[1]), "+v"(x[2]), "+v"(x[3]), "+v"(x[4]), "+v"(x[5]), "+v"(x[6]), "+v"(x[7]), "+v"(x[8]), "+v"(x[9]), "+v"(x[10]), "+v"(x[11]), "+v"(x[12]), "+v"(x[13]), "+v"(x[14]), "+v"(x[15]));
        asm volatile("" : "+v"(x[16]), "+v"(x[17]), "+v"(x[18]), "+v"(x[19]), "+v"(x[20]), "+v"(x[21]), "+v"(x[22]), "+v"(x[23]), "+v"(x[24]), "+v"(x[25]), "+v"(x[26]), "+v"(x[27]), "+v"(x[28]), "+v"(x[29]), "+v"(x[30]), "+v"(x[31]));
        solve_cols<J + 1>(x, lrow);
    }
}
constexpr int DN_GROUP = 66560;
__device__ __forceinline__ void dn_chunk_item(const Params& P, int l, int item, unsigned char* lds, int tid_) {
    asm volatile("" : "+v"(tid_));
    const int tid = tid_, dir = tid >> 8, tg = tid & 255, wg = (tid >> 6) & 3, lane = tid & 63, fr = lane & 15, fq = lane >> 4;
    int seq, c, h, n, rowbase, slot;
    if (item < 256) { seq = item >> 4; c = (item >> 2) & 3; h = item & 3; n = 256; rowbase = seq * 256; slot = (seq * 8 + h * 2 + dir) * 4 + c; }
    else { const int it = item - 256; seq = it >> 8; c = (it >> 2) & 63; h = it & 3; n = 4096; rowbase = NPT + seq * 4096; slot = 512 + (seq * 8 + h * 2 + dir) * 64 + c; }
    unsigned char* L = lds + dir * DN_GROUP;
    bf16_t* sq = (bf16_t*)L; bf16_t* sk = sq + 64 * 72; bf16_t* sv = sk + 64 * 72; bf16_t* skT = sv + 64 * 72; bf16_t* sA = skT + 64 * 72;
    float* sL = (float*)(L + 46080); bf16_t* uT = (bf16_t*)(L + 46080); bf16_t* wT = uT + 64 * 72;
    float* sgc = (float*)(L + 46080 + 18432); float* sbeta = sgc + 64; float* sbe = sgc + 128; float* segl = sgc + 192; float* seg = sgc + 256;
    const bf16_t* PROJ = (const bf16_t*)(P.ws + WS_PROJ);
    const int r = tg >> 2, dq = (tg & 3) * 16;
    const int p = dir == 0 ? 64 * c + r : n - 1 - (64 * c + r);
    const bf16_t* pr = PROJ + (size_t)(rowbase + p) * INW;
    u32x4 raw[3][3][2];
#pragma unroll
    for (int mat = 0; mat < 3; ++mat)
#pragma unroll
        for (int j = 0; j < 3; ++j) { const int pp = p + j - 1; const bf16_t* q = pr + (ptrdiff_t)(j - 1) * INW + 1536 + mat * 256 + h * 64 + dq;
            if (pp >= 0 && pp < n) { raw[mat][j][0] = *(const u32x4*)q; raw[mat][j][1] = *(const u32x4*)(q + 8); }
            else { raw[mat][j][0] = (u32x4){0u, 0u, 0u, 0u}; raw[mat][j][1] = (u32x4){0u, 0u, 0u, 0u}; } }
    float beta_r, egl_r;
    {
        const int pg = dir == 0 ? 64 * c + lane : n - 1 - (64 * c + lane);
        const bf16_t* prg = PROJ + (size_t)(rowbase + pg) * INW;
        const float a = bf2f(prg[2560 + dir * 4 + h]), bb = bf2f(prg[2568 + dir * 4 + h]);
        const float Aexp = expf(P.in[18][l * 8 + dir * 4 + h]), dtb = P.in[19][l * 8 + dir * 4 + h];
        const float xx = a + dtb; const float sp = xx > 20.f ? xx : log1pf(expf(xx));
        float gcum = -Aexp * sp;
#pragma unroll
        for (int o = 1; o < 64; o <<= 1) { const float tt = shl_(gcum, (lane - o) & 63, lane); if (lane >= o) gcum += tt; }
        const float gl = shl_(gcum, 63, lane); const float beta = __builtin_amdgcn_rcpf(1.f + __expf(-bb)); const float egl = __expf(gl - gcum);
        if (wg == 0) { sgc[lane] = gcum; sbeta[lane] = beta; const float eg_ = __expf(gcum); sbe[lane] = beta * eg_; segl[lane] = egl; seg[lane] = eg_;
            if (lane == 63) ((float*)(P.ws + WS_DNG))[slot] = __expf(gl); }
        beta_r = shl_(beta, r, lane); egl_r = shl_(egl, r, lane);
    }
    {
#pragma unroll
        for (int mat = 0; mat < 3; ++mat) {
            const int ch0 = mat * 256 + h * 64 + dq;
            const float* cw = P.in[14] + (size_t)l * 3 * 768 + ch0;
            float x[16];
#pragma unroll
            for (int e = 0; e < 16; ++e) x[e] = 0.f;
#pragma unroll
            for (int j = 0; j < 3; ++j) { float v[16]; unpack8(raw[mat][j][0], v); unpack8(raw[mat][j][1], v + 8);
#pragma unroll
                for (int e4 = 0; e4 < 4; ++e4) { const f32x4 w = *(const f32x4*)(cw + j * 768 + 4 * e4);
                    x[4 * e4 + 0] += w[0] * v[4 * e4 + 0]; x[4 * e4 + 1] += w[1] * v[4 * e4 + 1]; x[4 * e4 + 2] += w[2] * v[4 * e4 + 2]; x[4 * e4 + 3] += w[3] * v[4 * e4 + 3]; } }
            float ss = 0.f;
#pragma unroll
            for (int e = 0; e < 16; ++e) { x[e] = x[e] * __builtin_amdgcn_rcpf(1.f + __expf(-x[e])); ss += x[e] * x[e]; }
            if (mat < 2) { ss += shx(ss, 1, lane); ss += shx(ss, 2, lane); const float rs = rsqrtf(ss + EPS) * (mat == 0 ? 0.125f : 1.f);
#pragma unroll
                for (int e = 0; e < 16; ++e) x[e] *= rs; }
            bf16_t* dst = sq + mat * (64 * 72) + r * 72 + dq;
            *(u32x4*)dst = pack8(x); *(u32x4*)(dst + 8) = pack8(x + 8);
            if (mat == 1) {
                float y[16];
#pragma unroll
                for (int e = 0; e < 16; ++e) y[e] = x[e] * beta_r;
                *(u32x4*)(sA + r * 72 + dq) = pack8(y); *(u32x4*)(sA + r * 72 + dq + 8) = pack8(y + 8);
#pragma unroll
                for (int e = 0; e < 16; ++e) skT[(dq + e) * 72 + r] = (bf16_t)f2bf(x[e] * egl_r);
            }
        }
    }
    __syncthreads();
    {
        f32x4 kk[4], qk[4];
        bf16x8 kf0[2], qf[2];
#pragma unroll
        for (int ks = 0; ks < 2; ++ks) { kf0[ks] = *(const bf16x8*)(sk + (16 * wg + fr) * 72 + 32 * ks + 8 * fq); qf[ks] = *(const bf16x8*)(sq + (16 * wg + fr) * 72 + 32 * ks + 8 * fq); }
#pragma unroll
        for (int nb = 0; nb < 4; ++nb) { kk[nb] = (f32x4){0.f, 0.f, 0.f, 0.f}; qk[nb] = (f32x4){0.f, 0.f, 0.f, 0.f};
#pragma unroll
            for (int ks = 0; ks < 2; ++ks) { const bf16x8 kbv = *(const bf16x8*)(sA + (16 * nb + fr) * 72 + 32 * ks + 8 * fq), kv = *(const bf16x8*)(sk + (16 * nb + fr) * 72 + 32 * ks + 8 * fq);
                kk[nb] = mfma16(kf0[ks], kbv, kk[nb]); qk[nb] = mfma16(qf[ks], kv, qk[nb]); } }
        __syncthreads();
#pragma unroll
        for (int nb = 0; nb < 4; ++nb)
#pragma unroll
            for (int jj = 0; jj < 4; ++jj) { const int a = 16 * wg + 4 * fq + jj, bb = 16 * nb + fr;
                const float ga = sgc[a], gb = sgc[bb];
                const float ed = __expf(bb > a ? gb - ga : ga - gb);
                const float decL = bb > a ? ed : 0.f;
                const float decA = a >= bb ? ed : 0.f;
                sL[a * 68 + (bb & 1) * 32 + (bb >> 1)] = kk[nb][jj] * decL;
                sA[a * 72 + bb] = (bf16_t)f2bf(qk[nb][jj] * decA); }
    }
    __syncthreads();
    {
        const int col = tg >> 1, par = tg & 1;
        const bf16_t* src = (col < 64 ? sv + col : sk + (col - 64)) + par * 72;
        const float* scl = (col < 64 ? sbeta : sbe) + par;
        float x[32];
#pragma unroll
        for (int r = 0; r < 32; ++r) x[r] = bf2f(src[2 * r * 72]) * scl[2 * r];
        solve_cols<0>(x, sL + 32 * par);
        __syncthreads();
        bf16_t* dst = (col < 64 ? uT + col * 72 : wT + (col - 64) * 72) + 32 * par;
        unsigned w[16];
#pragma unroll
        for (int k = 0; k < 32; ++k) {
            const float other = __int_as_float(__builtin_amdgcn_update_dpp(0, __float_as_int(x[k]), 0xB1, 0xf, 0xf, false));
            if (k < 16) { if (par == 0) w[k] = pk2(x[k], other); } else { if (par == 1) w[k - 16] = pk2(other, x[k]); }
        }
#pragma unroll
        for (int e4 = 0; e4 < 4; ++e4) *(u32x4*)(dst + 8 * e4) = (u32x4){w[4 * e4], w[4 * e4 + 1], w[4 * e4 + 2], w[4 * e4 + 3]};
    }
    __syncthreads();
    {
        bf16x8 af[2], kf[2];
#pragma unroll
        for (int ks = 0; ks < 2; ++ks) { af[ks] = *(const bf16x8*)(sA + (16 * wg + fr) * 72 + 32 * ks + 8 * fq); kf[ks] = *(const bf16x8*)(skT + (16 * wg + fr) * 72 + 32 * ks + 8 * fq); }
        bf16_t* gM = (bf16_t*)(P.ws + WS_DN) + (size_t)slot * 4096; bf16_t* gB = (bf16_t*)(P.ws + WS_DN + DN_MAT) + (size_t)slot * 4096; bf16_t* gQ = (bf16_t*)(P.ws + WS_DN + 2 * DN_MAT) + (size_t)slot * 4096;
        const int irow = 16 * wg + fr;
        const int pi = dir == 0 ? 64 * c + irow : n - 1 - (64 * c + irow);
        bf16_t* gO = (bf16_t*)(P.ws + WS_OFB) + ((size_t)dir * NTOK + rowbase + pi) * 256 + h * 64;
        const float eg_i = seg[irow];
#pragma unroll
        for (int nb = 0; nb < 4; ++nb) {
            f32x4 aw = (f32x4){0.f, 0.f, 0.f, 0.f}, au = aw, mx = aw, bx = aw;
#pragma unroll
            for (int ks = 0; ks < 2; ++ks) { const bf16x8 wf = *(const bf16x8*)(wT + (16 * nb + fr) * 72 + 32 * ks + 8 * fq), uf = *(const bf16x8*)(uT + (16 * nb + fr) * 72 + 32 * ks + 8 * fq);
                aw = mfma16(wf, af[ks], aw); au = mfma16(uf, af[ks], au); mx = mfma16(wf, kf[ks], mx); bx = mfma16(kf[ks], uf, bx); }
            const int cc = 16 * nb + 4 * fq;
            u32x2 w;
            const int fo = (((wg * 2 + (cc >> 5)) * 64 + ((cc & 31) >> 3) * 16 + fr) * 8 + (cc & 7));
            w.x = pk2(-mx[0], -mx[1]); w.y = pk2(-mx[2], -mx[3]); *(u32x2*)(gM + fo) = w;
            w.x = pk2(bx[0], bx[1]); w.y = pk2(bx[2], bx[3]); *(u32x2*)(gB + ((nb * 4 + wg) * 64 + fq * 16 + fr) * 4) = w;
            const u32x2 qq = *(const u32x2*)(sq + irow * 72 + cc);
            w.x = pk2(bf_lo(qq.x) * eg_i - aw[0], bf_hi(qq.x) * eg_i - aw[1]); w.y = pk2(bf_lo(qq.y) * eg_i - aw[2], bf_hi(qq.y) * eg_i - aw[3]); *(u32x2*)(gQ + fo) = w;
            w.x = pk2(au[0], au[1]); w.y = pk2(au[2], au[3]); *(u32x2*)(gO + cc) = w;
        }
    }
    lds_barrier();
}

template <int NT = 2, bool DRY = false> __device__ __forceinline__ void dn_scan_chain(const Params& P, int l, int chain, int vhalf, unsigned char* lds, int tid_) {
    const int tid = tid_, w = tid >> 6, lane = tid & 63, fr = lane & 15, fq = lane >> 4, rb = w >> 1, cb0 = NT == 2 ? (w & 1) * 2 : vhalf * 2 + (w & 1);
    int seq, h, dir, n, nc, rowbase, slot0; bool sample;
    if (chain < 128) { seq = chain >> 3; h = (chain >> 1) & 3; dir = chain & 1; n = 256; nc = 4; rowbase = seq * 256; slot0 = chain * 4; sample = false; }
    else { const int cc = chain - 128; seq = cc >> 3; h = (cc >> 1) & 3; dir = cc & 1; n = 4096; nc = 64; rowbase = NPT + seq * 4096; slot0 = 512 + cc * 64; sample = true; }
    bf16_t* ST = (bf16_t*)lds;
    const size_t sidx = ((size_t)((seq * 2 + l) * 2 + dir) * 4 + h) * 4096;
    f32x4 S[NT];
#pragma unroll
    for (int t = 0; t < NT; ++t) { const int v = 16 * (cb0 + t) + fr;
#pragma unroll
        for (int jj = 0; jj < 4; ++jj) S[t][jj] = sample ? P.in[4][sidx + (16 * rb + 4 * fq + jj) * 64 + v] : 0.f;
        u32x2 wv; wv.x = pk2(S[t][0], S[t][1]); wv.y = pk2(S[t][2], S[t][3]); *(u32x2*)(ST + v * 72 + 16 * rb + 4 * fq) = wv; }
    __syncthreads();
    const bf16_t* gMb = (const bf16_t*)(P.ws + WS_DN); const bf16_t* gBb = (const bf16_t*)(P.ws + WS_DN + DN_MAT); const bf16_t* gQb = (const bf16_t*)(P.ws + WS_DN + 2 * DN_MAT);
    const float* gG = (const float*)(P.ws + WS_DNG);
    bf16_t* OFB = (bf16_t*)(P.ws + WS_OFB) + (size_t)dir * NTOK * 256;
    auto load_step = [&](int c, bf16x8 (&M_)[2], bf16x8 (&Q_)[2], float& eg_, u32x2 (&bt_)[NT], u32x2 (&o0_)[NT]) {
        const int slot = slot0 + c;
        const bf16_t* gM = gMb + (size_t)slot * 4096; const bf16_t* gB = gBb + (size_t)slot * 4096; const bf16_t* gQ = gQb + (size_t)slot * 4096;
#pragma unroll
        for (int ks = 0; ks < 2; ++ks) { M_[ks] = *(const bf16x8*)(gM + ((rb * 2 + ks) * 64 + lane) * 8); Q_[ks] = *(const bf16x8*)(gQ + ((rb * 2 + ks) * 64 + lane) * 8); }
        eg_ = gG[slot];
        const int il = 16 * rb + fr; const int pi = dir == 0 ? 64 * c + il : n - 1 - (64 * c + il);
        const bf16_t* orow = OFB + (size_t)(rowbase + pi) * 256 + h * 64;
#pragma unroll
        for (int t = 0; t < NT; ++t) { const int cb = cb0 + t; bt_[t] = *(const u32x2*)(gB + ((cb * 4 + rb) * 64 + lane) * 4); o0_[t] = *(const u32x2*)(orow + 16 * cb + 4 * fq); }
    };
    bf16x8 Mr[4][2], Qr[4][2]; float er[4]; u32x2 br[4][NT], orr[4][NT];
#pragma unroll
    for (int k = 0; k < 4; ++k) load_step(k, Mr[k], Qr[k], er[k], br[k], orr[k]);
    for (int c0 = 0; c0 < nc; c0 += 4) {
#pragma unroll
        for (int k = 0; k < 4; ++k) {
            const int c = c0 + k, cur = k & 1;
            const int il = 16 * rb + fr; const int pi = dir == 0 ? 64 * c + il : n - 1 - (64 * c + il);
            bf16_t* orow = OFB + (size_t)(rowbase + pi) * 256 + h * 64;
            const float egc = er[k];
#pragma unroll
            for (int t = 0; t < NT; ++t) { const int cb = cb0 + t;
                const u32x2 bt = br[k][t], o0 = orr[k][t];
                bf16x8 Sf[2];
#pragma unroll
                for (int ks = 0; ks < 2; ++ks) Sf[ks] = *(const bf16x8*)(ST + cur * 64 * 72 + (16 * cb + fr) * 72 + 32 * ks + 8 * fq);
                f32x4 o = (f32x4){bf_lo(o0.x), bf_hi(o0.x), bf_lo(o0.y), bf_hi(o0.y)};
                o = mfma16(Sf[0], Qr[k][0], o); o = mfma16(Sf[1], Qr[k][1], o);
                u32x2 wv; wv.x = pk2(o[0], o[1]); wv.y = pk2(o[2], o[3]); if (!DRY || o[0] == 1234.5f) *(u32x2*)(orow + 16 * cb + 4 * fq) = wv;
                f32x4 s = S[t] * egc + (f32x4){bf_lo(bt.x), bf_hi(bt.x), bf_lo(bt.y), bf_hi(bt.y)};
                s = mfma16(Mr[k][0], Sf[0], s); s = mfma16(Mr[k][1], Sf[1], s);
                S[t] = s;
                wv.x = pk2(s[0], s[1]); wv.y = pk2(s[2], s[3]); *(u32x2*)(ST + (cur ^ 1) * 64 * 72 + (16 * cb + fr) * 72 + 16 * rb + 4 * fq) = wv;
            }
            if (c + 4 < nc) load_step(c + 4, Mr[k], Qr[k], er[k], br[k], orr[k]);
            lds_barrier();
        }
    }
    if (!sample && !DRY) {
#pragma unroll
        for (int t = 0; t < NT; ++t) { const int v = 16 * (cb0 + t) + fr;
#pragma unroll
            for (int jj = 0; jj < 4; ++jj) P.out[OUT_S + sidx + (16 * rb + 4 * fq + jj) * 64 + v] = S[t][jj]; }
    }
    __syncthreads();
}

__device__ __forceinline__ void attn_unit(const Params& P, int l, int unit, unsigned char* lds, int tid_) {
    const int tid = tid_, w = tid >> 6, lane = tid & 63, fr = lane & 15, fq = lane >> 4;
    bool sample; int seq, kvh, qb;
    if (unit < 512) { sample = true; seq = unit >> 7; kvh = (unit >> 6) & 1; qb = unit & 63; }
    else { const int u2 = unit - 512; sample = false; seq = u2 >> 3; kvh = (u2 >> 2) & 1; qb = u2 & 3; }
    const int g = w >> 1, hq = kvh * 4 + g, q0 = qb * 64, qoff = (w & 1) * 32;
    const int rowbase = sample ? NPT + seq * 4096 : seq * 256, n = sample ? 4096 : 256;
    const bf16_t* PROJ = (const bf16_t*)(P.ws + WS_PROJ);
    bf16_t* Ks = (bf16_t*)lds;
    bf16_t* VT = Ks + 2 * 64 * 72;
    bf16x8 Qf[2][2];
#pragma unroll
    for (int qk = 0; qk < 2; ++qk)
#pragma unroll
        for (int ks = 0; ks < 2; ++ks) Qf[qk][ks] = *(const bf16x8*)(PROJ + (size_t)(rowbase + q0 + qoff + 16 * qk + fr) * INW + 768 + hq * 64 + 32 * ks + 8 * fq);
    const float sinkv = P.in[17][l * 8 + hq] * LOG2E;
    float mrun[2] = {sinkv, sinkv}, lsum[2] = {fq == 0 ? 1.f : 0.f, fq == 0 ? 1.f : 0.f};
    f32x4 O[2][4];
#pragma unroll
    for (int a = 0; a < 2; ++a)
#pragma unroll
        for (int b = 0; b < 4; ++b) O[a][b] = (f32x4){0.f, 0.f, 0.f, 0.f};
    int jlo = 0, jhi = 0, ntile;
    if (sample) { jlo = q0 >= 128 ? 0 : (128 - q0) / 64; jhi = (n + 64 - q0) / 64; if (jhi > 4) jhi = 4; ntile = 8 + (jhi - jlo + 1); } else ntile = 4;
    const int key = tid >> 3, dch = (tid & 7) * 8;
    auto load_tile = [&](int t, u32x4& kreg, u32x4& vreg) {
        if (sample && t < 8) {
            const size_t ci = ((size_t)(seq * 512 + 64 * t + key)) * 128 + kvh * 64 + dch;
            kreg = *(const u32x4*)((const bf16_t*)(P.ws + WS_CK) + ci); vreg = *(const u32x4*)((const bf16_t*)(P.ws + WS_CV) + ci);
        } else {
            const int ts = sample ? q0 - 128 + 64 * (jlo + t - 8) : 64 * t;
            const bf16_t* pr = PROJ + (size_t)(rowbase + ts + key) * INW + kvh * 64 + dch;
            kreg = *(const u32x4*)(pr + 1280); vreg = *(const u32x4*)(pr + 1408);
        }
    };
    auto store_tile = [&](int buf, const u32x4& kreg, const u32x4& vreg) {
        *(u32x4*)(Ks + buf * 64 * 72 + key * 72 + dch) = kreg;
        *(u32x4*)(VT + buf * 64 * 72 + key * 72 + dch) = vreg;
    };
    u32x4 kr[3], vr[3];
    load_tile(0, kr[0], vr[0]); store_tile(0, kr[0], vr[0]);
#pragma unroll
    for (int k = 0; k < 3; ++k) if (k + 1 < ntile) load_tile(k + 1, kr[k], vr[k]);
    lds_barrier();
    for (int t0 = 0; t0 < ntile; t0 += 3) {
#pragma unroll
        for (int k = 0; k < 3; ++k) {
            const int t = t0 + k;
            if (t < ntile) {
        const int cur = t & 1;
        const bf16_t* Kc = Ks + cur * 64 * 72; const bf16_t* Vc = VT + cur * 64 * 72;
        const int jw = jlo + t - 8;
        const bool masked = sample && t >= 8 && (jw == 0 || jw == 4);
        const int ts = masked ? q0 - 128 + 64 * jw : 0;
        f32x4 s[2][4];
#pragma unroll
        for (int kb = 0; kb < 4; ++kb) {
            bf16x8 kf[2];
#pragma unroll
            for (int ks = 0; ks < 2; ++ks) kf[ks] = *(const bf16x8*)(Kc + (16 * kb + fr) * 72 + 32 * ks + 8 * fq);
#pragma unroll
            for (int qk = 0; qk < 2; ++qk) { f32x4 a = (f32x4){0.f, 0.f, 0.f, 0.f}; a = mfma16(kf[0], Qf[qk][0], a); a = mfma16(kf[1], Qf[qk][1], a); s[qk][kb] = a; }
        }
        bf16x8 pf[2][2];
#pragma unroll
        for (int qk = 0; qk < 2; ++qk) {
            if (masked) { const int qp = q0 + qoff + 16 * qk + fr;
#pragma unroll
                for (int kb = 0; kb < 4; ++kb)
#pragma unroll
                    for (int jj = 0; jj < 4; ++jj) { const int kp = ts + 16 * kb + 4 * fq + jj; const int df = qp - kp; if (df > 128 || df < -128) s[qk][kb][jj] = -1e30f; } }
            float mx = s[qk][0][0];
#pragma unroll
            for (int kb = 0; kb < 4; ++kb)
#pragma unroll
                for (int jj = 0; jj < 4; ++jj) mx = fmaxf(mx, s[qk][kb][jj]);
            mx = fmaxf(mx, shx(mx, 16, lane)); mx = fmaxf(mx, shx(mx, 32, lane));
            const float mnew = fmaxf(mrun[qk], mx); const float alpha = __builtin_amdgcn_exp2f(mrun[qk] - mnew); mrun[qk] = mnew;
            float ps = 0.f;
#pragma unroll
            for (int kb = 0; kb < 4; ++kb)
#pragma unroll
                for (int jj = 0; jj < 4; ++jj) { const float p = __builtin_amdgcn_exp2f(s[qk][kb][jj] - mnew); s[qk][kb][jj] = p; ps += p; }
            lsum[qk] = lsum[qk] * alpha + ps;
            if (__builtin_amdgcn_ballot_w64(alpha != 1.f) != 0ull) {
#pragma unroll
                for (int db = 0; db < 4; ++db) O[qk][db] = O[qk][db] * alpha; }
#pragma unroll
            for (int m2 = 0; m2 < 2; ++m2) { u32x4 pw; pw.x = pk2(s[qk][2 * m2][0], s[qk][2 * m2][1]); pw.y = pk2(s[qk][2 * m2][2], s[qk][2 * m2][3]);
                pw.z = pk2(s[qk][2 * m2 + 1][0], s[qk][2 * m2 + 1][1]); pw.w = pk2(s[qk][2 * m2 + 1][2], s[qk][2 * m2 + 1][3]); pf[qk][m2] = as_bf8(pw); }
        }
#pragma unroll
        for (int db = 0; db < 4; ++db)
#pragma unroll
            for (int m2 = 0; m2 < 2; ++m2) {
                const bf16_t* vp = Vc + (32 * m2 + 4 * fq + (fr >> 2)) * 72 + 16 * db + 4 * (fr & 3);
                const v4i16_t t0 = __builtin_amdgcn_ds_read_tr16_b64_v4i16((LAS v4i16_t*)vp), t1 = __builtin_amdgcn_ds_read_tr16_b64_v4i16((LAS v4i16_t*)(vp + 16 * 72));
                const bf16x8 vf = __builtin_shufflevector(__builtin_bit_cast(bf16x4_t, t0), __builtin_bit_cast(bf16x4_t, t1), 0, 1, 2, 3, 4, 5, 6, 7);
                O[0][db] = mfma16(vf, pf[0][m2], O[0][db]); O[1][db] = mfma16(vf, pf[1][m2], O[1][db]); }
        if (t + 1 < ntile) store_tile(cur ^ 1, kr[k], vr[k]);
        if (t + 4 < ntile) load_tile(t + 4, kr[k], vr[k]);
        lds_barrier();
            }
        }
    }
    bf16_t* MIX = (bf16_t*)(P.ws + WS_ABUF);
#pragma unroll
    for (int qk = 0; qk < 2; ++qk) { float lt = lsum[qk]; lt += shx(lt, 16, lane); lt += shx(lt, 32, lane); const float inv = __builtin_amdgcn_rcpf(lt);
        bf16_t* orow = MIX + (size_t)(rowbase + q0 + qoff + 16 * qk + fr) * D + 256 + hq * 64;
#pragma unroll
        for (int db = 0; db < 4; ++db) { const f32x4 o = O[qk][db] * inv; u32x2 wv; wv.x = pk2(o[0], o[1]); wv.y = pk2(o[2], o[3]); *(u32x2*)(orow + 16 * db + 4 * fq) = wv; } }
}

__device__ __forceinline__ void convert_gu_dn(const Params& P, int l, unsigned char* lds, int tid_, int gw, int NGW) {
    const int lane = tid_ & 63, wave = tid_ >> 6;
    float* scr = (float*)(lds + wave * 8448);
    constexpr int I_G = 16 * 88, I_D = 44 * 32;
    for (int it = gw; it < 2 * I_G + I_D; it += NGW) {
        int r = it;
        if (r < I_G) { transpose_item<1>(P.in[21] + (size_t)l * 1024 * FF, 1024, FF, 88, (bf16_t*)(P.ws + WS_WGU), scr, r, lane); continue; } r -= I_G;
        if (r < I_G) { transpose_item<2>(P.in[22] + (size_t)l * 1024 * FF, 1024, FF, 88, (bf16_t*)(P.ws + WS_WGU), scr, r, lane); continue; } r -= I_G;
        transpose_item<0>(P.in[23] + (size_t)l * FF * 1024, FF, 1024, 32, (bf16_t*)(P.ws + WS_WDN), scr, r, lane);
    }
}

__device__ __forceinline__ void convert_in_out_l1(const Params& P, unsigned char* lds, int tid_, int gw, int NGW) {
    const int lane = tid_ & 63, wave = tid_ >> 6;
    float* scr = (float*)(lds + wave * 8448);
    constexpr int I_IN = 16 * 88;
    for (int it = gw; it < I_IN; it += NGW) transpose_item<0>(P.in[7] + (size_t)1024 * INW, 1024, INW, 88, (bf16_t*)(P.ws + WS_WIN) + (size_t)INP * 1024, scr, it, lane);
}

__device__ __forceinline__ void phase_e(const Params& P, int l, unsigned char* lds, int tid_, int bid_, int G_) {
    const int tid = tid_, lane = tid & 63, wave = tid >> 6, G = G_;
    const int gw = bid_ * 8 + wave, NGW = G * 8;
    float* scr = (float*)(lds + wave * 8448);
    constexpr int I_O = 16 * 32;
    for (int it = gw; it < I_O; it += NGW) transpose_item<0>(P.in[8] + (size_t)l * 1024 * 1024, 1024, 1024, 32, (bf16_t*)(P.ws + WS_WOUT), scr, it, lane);
    const bf16_t* PROJ = (const bf16_t*)(P.ws + WS_PROJ); const bf16_t* OF = (const bf16_t*)(P.ws + WS_OFB); const bf16_t* OB = OF + (size_t)NTOK * 256;
    bf16_t* MIX = (bf16_t*)(P.ws + WS_ABUF);
    const float* ng = P.in[20] + l * 64;
    const int c4 = lane * 4;
    u32x2 a = (u32x2){0u, 0u}, b = a, z = a;
    if (gw < NTOK) { a = *(const u32x2*)(OF + (size_t)gw * 256 + c4); b = *(const u32x2*)(OB + (size_t)gw * 256 + c4); z = *(const u32x2*)(PROJ + (size_t)gw * INW + 2304 + c4); }
    for (int row = gw; row < NTOK; row += NGW) {
        u32x2 an = a, bn = b, zn = z; const int nr = row + NGW;
        if (nr < NTOK) { an = *(const u32x2*)(OF + (size_t)nr * 256 + c4); bn = *(const u32x2*)(OB + (size_t)nr * 256 + c4); zn = *(const u32x2*)(PROJ + (size_t)nr * INW + 2304 + c4); }
        float o[4] = {bf_lo(a.x) + bf_lo(b.x), bf_hi(a.x) + bf_hi(b.x), bf_lo(a.y) + bf_lo(b.y), bf_hi(a.y) + bf_hi(b.y)};
        float ss = o[0] * o[0] + o[1] * o[1] + o[2] * o[2] + o[3] * o[3];
        ss += shx(ss, 1, lane); ss += shx(ss, 2, lane); ss += shx(ss, 4, lane); ss += shx(ss, 8, lane);
        const float rs = rsqrtf(ss * (1.f / 64.f) + EPS);
        const f32x4 gg = *(const f32x4*)(ng + (c4 & 63));
        const float zz[4] = {bf_lo(z.x), bf_hi(z.x), bf_lo(z.y), bf_hi(z.y)};
        float y[4];
#pragma unroll
        for (int k = 0; k < 4; ++k) y[k] = o[k] * rs * gg[k] * siluf(zz[k]);
        u32x2 wv; wv.x = pk2(y[0], y[1]); wv.y = pk2(y[2], y[3]);
        *(u32x2*)(MIX + (size_t)row * D + 768 + c4) = wv;
        a = an; b = bn; z = zn;
    }
}


#define XB_TMO      128
#define XB_XCNT(j)  (256  + 64 * (j))
#define XB_XSUB(j)  (1280 + 64 * (j))
#define XB_XGEN(j)  (2304 + 64 * (j))
#define XB_TOP      3328
#define XB_TOPGEN   3392
#define XCD_BAR_WORDS 3456
#define XB_SPIN_CAP (1u << 18)
__device__ __forceinline__ unsigned xb_ld(unsigned* p)              { return __hip_atomic_load(p, __ATOMIC_RELAXED, __HIP_MEMORY_SCOPE_AGENT); }
__device__ __forceinline__ unsigned xb_add(unsigned* p, unsigned v) { return __hip_atomic_fetch_add(p, v, __ATOMIC_RELAXED, __HIP_MEMORY_SCOPE_AGENT); }
__device__ __forceinline__ unsigned xb_xcc_id() { return (unsigned)__builtin_amdgcn_s_getreg((3 << 11) | 20) & 0xFu; }
#define XB_SPIN(cond, bar) do { unsigned _sp = 0; while (cond) { __builtin_amdgcn_s_sleep(1); \
    if ((++_sp & 255u) == 0u) { if (xb_ld(&(bar)[XB_TMO])) break; if (_sp > XB_SPIN_CAP) { atomicAdd(&(bar)[XB_TMO], 1u); break; } } } } while (0)
__device__ __forceinline__ void xcd_barrier_complete(unsigned* bar, unsigned x, unsigned G, unsigned& nloc, unsigned& nx) {
    unsigned sum, cnt, mine, sp = 0u;
    for (;;) {
        sum = 0u; cnt = 0u; mine = 0u;
#pragma unroll
        for (unsigned j = 0; j < 16; ++j) { const unsigned c = xb_ld(&bar[XB_XCNT(j)]); sum += c; cnt += (c > 0u) ? 1u : 0u; mine = (j == x) ? c : mine; }
        if (sum == G) break;
        __builtin_amdgcn_s_sleep(1);
        if ((++sp & 255u) == 0u) { if (xb_ld(&bar[XB_TMO])) break; if (sp > XB_SPIN_CAP) { atomicAdd(&bar[XB_TMO], 1u); break; } }
    }
    nloc = mine > 0u ? mine : 1u; nx = cnt > 0u ? cnt : 1u;
}
__device__ __forceinline__ void xcd_barrier(unsigned* bar, volatile LAS unsigned* st, int tid_, unsigned G) {
    asm volatile("s_waitcnt vmcnt(0)" ::: "memory");
    __syncthreads();
    if (tid_ == 0) {
        const unsigned x = xb_xcc_id();
        __builtin_amdgcn_s_waitcnt(0);
        unsigned nloc = st[0], nx = st[1];
        if (nloc == 0u) { xcd_barrier_complete(bar, x, G, nloc, nx); st[0] = nloc; st[1] = nx; }
        const unsigned old = xb_add(&bar[XB_XSUB(x)], 1u);
        const unsigned gen = old / nloc;
        if (old + 1u == (gen + 1u) * nloc) {
            __builtin_amdgcn_fence(__ATOMIC_RELEASE, "agent");
            asm volatile("s_waitcnt vmcnt(0)" ::: "memory");
            const unsigned og = xb_add(&bar[XB_TOP], 1u);
            const unsigned tg = og / nx;
            if (og + 1u == (tg + 1u) * nx) xb_add(&bar[XB_TOPGEN], 1u);
            else XB_SPIN(xb_ld(&bar[XB_TOPGEN]) == tg, bar);
            __builtin_amdgcn_fence(__ATOMIC_ACQUIRE, "agent");
            xb_add(&bar[XB_XGEN(x)], 1u);
            asm volatile("s_waitcnt vmcnt(0)" ::: "memory");
        } else {
            XB_SPIN(xb_ld(&bar[XB_XGEN(x)]) == gen, bar);
            __builtin_amdgcn_fence(__ATOMIC_ACQUIRE, "agent");
            asm volatile("s_waitcnt vmcnt(0)" ::: "memory");
        }
    }
    __syncthreads();
}

__global__ void __launch_bounds__(512, 2) trunk_fwd(Params P0) {
    extern __shared__ __attribute__((aligned(16))) unsigned char lds[];
    cg::grid_group grid = cg::this_grid();
    const int G0 = gridDim.x, b0 = blockIdx.x;
    const int wave0 = __builtin_amdgcn_readfirstlane(threadIdx.x >> 6);
    const int ph_lo = P0.ph_lo, ph_hi = P0.ph_hi;
    {
        unsigned long long* tb = (unsigned long long*)(lds + PTAB_OFF);
        if (threadIdx.x == 0) {
#pragma unroll
            for (int i = 0; i < 24; ++i) tb[i] = (unsigned long long)P0.in[i];
            tb[24] = (unsigned long long)P0.out; tb[25] = (unsigned long long)P0.ws;
            tb[28] = 0ull;
        }
        if (threadIdx.x == 0) (void)xb_add(&((unsigned*)(P0.ws + WS_BAR))[XB_XCNT(xb_xcc_id())], 1u);
        __syncthreads();
    }
    for (int ph = ph_lo; ph < ph_hi; ++ph) {
        int tid, G = G0, b = b0;
        asm volatile("v_mbcnt_lo_u32_b32 %0, -1, 0\n\tv_mbcnt_hi_u32_b32 %0, -1, %0" : "=v"(tid) : : "memory"); tid += wave0 * 64;
        asm volatile("" : "+s"(G), "+s"(b));
        if (ph > ph_lo) {
            unsigned char* wsb; { unsigned tboff = PTAB_OFF; asm volatile("" : "+v"(tboff)); wsb = (unsigned char*)(__attribute__((address_space(1))) unsigned char*)uni64(((const unsigned long long*)(lds + tboff))[25]); }
            xcd_barrier((unsigned*)(wsb + WS_BAR), (volatile LAS unsigned*)(lds + PTAB_OFF + 224), tid, (unsigned)G);
            if (ph_hi > 1000) grid.sync();
        }
        Params P;
        {   unsigned tboff = PTAB_OFF; asm volatile("" : "+v"(tboff));
            const unsigned long long* tb = (const unsigned long long*)(lds + tboff);
#pragma unroll
            for (int i = 0; i < 24; ++i) P.in[i] = (const float*)(const __attribute__((address_space(1))) float*)uni64(tb[i]);
            P.out = (float*)(__attribute__((address_space(1))) float*)uni64(tb[24]); P.ws = (unsigned char*)(__attribute__((address_space(1))) unsigned char*)uni64(tb[25]); P.ph_lo = 0; P.ph_hi = 0; }
        float* X = P.out;
        const float* modw = (const float*)(P.ws + WS_MOD);
        bf16_t* ABUF = (bf16_t*)(P.ws + WS_ABUF);
        if (ph == 0) { phase0(P, lds, tid, b, G); continue; }
        const int l = (ph - 1) / 9, sub = (ph - 1) % 9;
        const float* modl = modw + (size_t)l * 5 * 6144;
        const float* xa = l == 0 ? P.in[0] : X; const float* xb = l == 0 ? P.in[1] : X + (size_t)NPT * D;
        if (sub == 1 || sub == 5 || sub == 7 || sub == 8) {
            pg8::Gemm g; EpiAny E;
            const bool s1 = sub == 1, s5 = sub == 5, s7 = sub == 7, s8 = sub == 8;
            unsigned long long a_off = s8 ? WS_PROJ : WS_ABUF;
            unsigned long long b_off = s1 ? WS_WIN + (unsigned long long)l * INP * 1024 * 2 : (s5 ? WS_WOUT : (s7 ? WS_WGU : WS_WDN));
            int nn = s1 ? INP : (s7 ? FF2 : D), kk = s8 ? FF : D, mode = s1 ? 0 : (s7 ? 2 : 1), goff = s8 ? 5120 : 2048;
            const float* exa = s5 ? xa : X; const float* exb = s5 ? xb : X + (size_t)NPT * D;
            asm volatile("" : "+s"(a_off), "+s"(b_off), "+s"(nn), "+s"(kk), "+s"(mode), "+s"(goff), "+s"(exa), "+s"(exb));
            g.M = NTOK; g.A = (const bf16_t*)(P.ws + a_off); g.Bt = (const bf16_t*)(P.ws + b_off); g.N = nn; g.K = kk;
            E.O = (bf16_t*)(P.ws + WS_PROJ); E.xa = exa; E.xb = exb; E.modl = modl; E.out = X; E.goff = goff; E.mode = mode; E.perm = mode != 1;
            pg8::StaticOrder S; S.init(NTOK, g.N, G, b);
            pg8::gemm_phase<EpiAny, pg8::StaticOrder, true, true>((LAS unsigned char*)lds, g, S, E, tid);
            if (s5) {
                const int two = 320 - G;
                const int first = (two > 0 && two < G) ? two : 0, nh = G - first;
                if (b >= first) { __syncthreads(); convert_gu_dn(P, l, lds, tid, (b - first) * 8 + (tid >> 6), nh * 8); }
            }
            if (s8 && l == 0) {
                const int two = 320 - G; const int first = (two > 0 && two < G) ? two : 0, nh = G - first;
                if (b >= first) { __syncthreads(); convert_in_out_l1(P, lds, tid, (b - first) * 8 + (tid >> 6), nh * 8); }
            }
            continue;
        }
        switch (sub) {
        case 0: norm_phase(xa, xb, P.in[11] + l * D, modl, 0, 1024, ABUF, tid, b, G);
            break;
        case 2: { prep_rows(P, l, lds, tid, b, G); for (int it = b; it < 1280; it += G) dn_chunk_item(P, l, it, lds, tid);
        } break;
        case 3: {
            const int nA = G > 128 ? 64 : 0;
            if (b < nA) { dn_scan_chain<1>(P, l, 128 + (b >> 1), b & 1, lds, tid); }
            else { const int bb = b - nA, GB = G - nA;
                if (nA == 0) for (int ch = bb; ch < 32; ch += GB) dn_scan_chain<2>(P, l, 128 + ch, 0, lds, tid);
                for (int ch = bb; ch < 128; ch += GB) dn_scan_chain<2>(P, l, ch, 0, lds, tid);
            }
            {
                unsigned* ctr = (unsigned*)(P.ws + WS_BAR) + 3584 + 64 * l;
                volatile LAS unsigned* wsl = (volatile LAS unsigned*)(lds + PTAB_OFF + 232);
                for (;;) {
                    __syncthreads();
                    if (tid == 0) wsl[0] = xb_add(ctr, 1u);
                    __syncthreads();
                    const unsigned u = wsl[0];
                    if (u >= 640u) break;
                    attn_unit(P, l, (int)u, lds, tid);
                }
            }
        } break;
        case 4: phase_e(P, l, lds, tid, b, G);
            break;
        case 6: norm_phase(X, X + (size_t)NPT * D, P.in[12] + l * D, modl, 3072, 4096, ABUF, tid, b, G); break;
        default: break;
        }
    }
}

extern "C" void kernel_launch(void* const* d_in, const int* in_sizes, int n_in, void* d_out, int out_size, void* d_ws, size_t ws_size, hipStream_t stream) {
    static int grid = 0;
    if (grid == 0) {
        if (n_in != 24 || ws_size < WS_END) { fprintf(stderr, "kernel_launch: unexpected n_in %d / ws %zu (need %zu)\n", n_in, ws_size, (size_t)WS_END); grid = -1; return; }
        int dev = 0, cus = 0, per_cu = 0;
        hipGetDevice(&dev); hipDeviceGetAttribute(&cus, hipDeviceAttributeMultiprocessorCount, dev);
        if (hipFuncSetAttribute((const void*)trunk_fwd, hipFuncAttributeMaxDynamicSharedMemorySize, LDS_BYTES) != hipSuccess) { fprintf(stderr, "hipFuncSetAttribute failed\n"); grid = -1; return; }
        if (hipOccupancyMaxActiveBlocksPerMultiprocessor(&per_cu, (const void*)trunk_fwd, 512, LDS_BYTES) != hipSuccess || per_cu < 1) { fprintf(stderr, "occupancy query failed (%d)\n", per_cu); per_cu = 1; }
        (void)hipGetLastError();
        grid = cus * (per_cu > 1 ? 1 : per_cu);
    }
    if (grid < 0) return;
    Params p{};
    for (int i = 0; i < 24; ++i) p.in[i] = (const float*)d_in[i];
    p.out = (float*)d_out; p.ws = (unsigned char*)d_ws; p.ph_lo = 0; p.ph_hi = 19;
    if (hipMemsetAsync((unsigned char*)d_ws + WS_BAR, 0, 16384, stream) != hipSuccess) { fprintf(stderr, "hipMemsetAsync of the barrier words failed\n"); return; }
    void* args[] = {&p};
    hipError_t e = hipLaunchCooperativeKernel((const void*)trunk_fwd, dim3(grid), dim3(512), args, LDS_BYTES, stream);
    if (e != hipSuccess) fprintf(stderr, "cooperative launch failed: %s (grid %d)\n", hipGetErrorString(e), grid);
}
```

```cpp
#include <hip/hip_runtime.h>

#include <hip/hip_cooperative_groups.h>
#include <cstdio>
#include <cstdint>
namespace cg = cooperative_groups;

#define LAS __attribute__((address_space(3)))
typedef unsigned short bf16_t;
typedef short bf16x8 __attribute__((ext_vector_type(8)));
typedef float f32x4 __attribute__((ext_vector_type(4)));
typedef unsigned u32x4 __attribute__((ext_vector_type(4)));
typedef unsigned u32x2 __attribute__((ext_vector_type(2)));
typedef short v4i16_t __attribute__((ext_vector_type(4)));
typedef short bf16x4_t __attribute__((ext_vector_type(4)));

constexpr int D = 1024, NTOK = 20480, NPT = 4096, INW = 2576, INP = 2816, FF = 2816, FF2 = 5632;
constexpr float EPS = 1e-6f;
constexpr float LOG2E = 1.4426950408889634f;
constexpr size_t OUT_K = 20971520, OUT_V = 22020096, OUT_S = 23068672;
constexpr size_t WS_WIN = 0;
constexpr size_t WS_ABUF = 11534336;
constexpr size_t WS_PROJ = WS_ABUF + 41943040;
constexpr size_t WS_DN = WS_PROJ + 115343360;
constexpr size_t DN_MAT = 2560ull * 8192ull;
constexpr size_t WS_WOUT = WS_DN, WS_WGU = WS_DN + 2097152, WS_WDN = WS_WGU + 11534336;
constexpr size_t WS_OFB = WS_DN + 3 * DN_MAT;
constexpr size_t WS_MOD = WS_OFB + 20971520;
constexpr size_t WS_DNG = WS_MOD + 245760;
constexpr size_t WS_BAR = WS_DNG + 10240;
constexpr size_t WS_CK = WS_BAR + 16384;
constexpr size_t WS_CV = WS_CK + 524288;
constexpr size_t WS_END = WS_CV + 524288;
constexpr int LDS_BYTES = 147456;
constexpr int PTAB_OFF = LDS_BYTES - 256;

struct Params {
    const float* in[24];
    float* out; unsigned char* ws;
    int ph_lo, ph_hi;
};

__device__ __forceinline__ unsigned f2bf(float f) { unsigned u = __float_as_uint(f); return (u + 0x7fffu + ((u >> 16) & 1u)) >> 16; }
__device__ __forceinline__ unsigned pk2(float lo, float hi) { typedef float f32x2_t __attribute__((ext_vector_type(2))); typedef __bf16 bf16x2_t __attribute__((ext_vector_type(2))); f32x2_t v = {lo, hi}; return __builtin_bit_cast(unsigned, __builtin_convertvector(v, bf16x2_t)); }
__device__ __forceinline__ float bf_lo(unsigned u) { return __uint_as_float(u << 16); }
__device__ __forceinline__ float bf_hi(unsigned u) { return __uint_as_float(u & 0xffff0000u); }
__device__ __forceinline__ float bf2f(bf16_t b) { return __uint_as_float(((unsigned)b) << 16); }
__device__ __forceinline__ void unpack8(u32x4 r, float* x) {
    x[0] = bf_lo(r.x); x[1] = bf_hi(r.x); x[2] = bf_lo(r.y); x[3] = bf_hi(r.y); x[4] = bf_lo(r.z); x[5] = bf_hi(r.z); x[6] = bf_lo(r.w); x[7] = bf_hi(r.w);
}
__device__ __forceinline__ u32x4 pack8(const float* x) { u32x4 r; r.x = pk2(x[0], x[1]); r.y = pk2(x[2], x[3]); r.z = pk2(x[4], x[5]); r.w = pk2(x[6], x[7]); return r; }
__device__ __forceinline__ float siluf(float x) { return x * __builtin_amdgcn_rcpf(1.f + __expf(-x)); }
__device__ __forceinline__ int mi_of(int row) { return row < NPT ? 0 : 1 + ((row - NPT) >> 12); }
__device__ __forceinline__ f32x4 mfma16(bf16x8 a, bf16x8 b, f32x4 c) { return __builtin_amdgcn_mfma_f32_16x16x32_bf16(a, b, c, 0, 0, 0); }
__device__ __forceinline__ bf16x8 as_bf8(u32x4 v) { return __builtin_bit_cast(bf16x8, v); }

__device__ __forceinline__ float shx(float v, int m, int lane) { return __int_as_float(__builtin_amdgcn_ds_bpermute((lane ^ m) << 2, __float_as_int(v))); }
__device__ __forceinline__ float shl_(float v, int src, int  ) { return __int_as_float(__builtin_amdgcn_ds_bpermute(src << 2, __float_as_int(v))); }
__device__ __forceinline__ void lds_barrier() { asm volatile("s_waitcnt lgkmcnt(0)" ::: "memory"); __builtin_amdgcn_s_barrier(); asm volatile("" ::: "memory"); }
__device__ __forceinline__ unsigned long long uni64(unsigned long long v) { const unsigned lo = __builtin_amdgcn_readfirstlane((unsigned)v), hi = __builtin_amdgcn_readfirstlane((unsigned)(v >> 32)); return ((unsigned long long)hi << 32) | lo; }
namespace pg8 {
constexpr int BM = 256, BK = 64, HALF = 128, HTB = HALF * BK * 2, STAGE_BYTES = 8 * HTB, NXCD = 8, WGM = 8;
__host__ __device__ __forceinline__ int lds_byte(int r, int c) { const int st = (r >> 4) * 2 + (c >> 5), rr = r & 15, cc = c & 31, ob = rr * 64 + cc * 2; return st * 1024 + (ob ^ (((ob >> 9) & 1) << 5)); }
__host__ __device__ __forceinline__ void stage_rc(int b, int& R, int& C) { const int st = b / 1024, sb = b % 1024, swz = sb ^ (((sb >> 9) & 1) << 5); R = (st >> 1) * 16 + swz / 64; C = (st & 1) * 32 + (swz % 64) / 2; }
__host__ __device__ __forceinline__ int perm32(int rho) { const int n = rho >> 4, i = rho & 15; return 8 * (i >> 2) + 4 * n + (i & 3); }
struct Unit { int pm, pn; };
struct Gemm { const bf16_t* A; const bf16_t* Bt; int M, N, K; };
struct StaticOrder {
    int nM, nN, nwg, G, c;
    __device__ void init(int M, int N, int G_, int c_) { nM = M / BM; nN = N / BM; nwg = nM * nN; G = G_; c = c_; }
    __device__ bool next(int i, Unit& u) const {
        const long L = (long)i * G + c; if (L >= nwg) return false;
        int wgid = (int)L; { const int q = nwg / NXCD, r = nwg % NXCD, xcd = wgid % NXCD, off = wgid / NXCD; wgid = (xcd < r ? xcd * (q + 1) : r * (q + 1) + (xcd - r) * q) + off; }
        const int nig = WGM * nN, gid = wgid / nig, fm = gid * WGM, gsz = (nM - fm) < WGM ? (nM - fm) : WGM;
        u.pm = fm + ((wgid % nig) % gsz); u.pn = (wgid % nig) / gsz; return true;
    }
};
__device__ __forceinline__ unsigned cvt_pk_bf16(float lo, float hi) { unsigned r; asm volatile("v_cvt_pk_bf16_f32 %0, %1, %2" : "=v"(r) : "v"(lo), "v"(hi)); return r; }

template <class Epi, class Sched, bool ALIGN_EPI = false, bool SP2 = false>
__device__ __forceinline__ void gemm_phase(LAS unsigned char* lds, const Gemm g, const Sched& S, const Epi& E, int tid_) {
    const int tid = tid_, wid = __builtin_amdgcn_readfirstlane(tid >> 6), lane = tid & 63, wr = wid >> 2, wc = wid & 3, fr = lane & 15, fq = lane >> 4;
    const int K = g.K, nt = K / BK;
    unsigned voffA[2], voffB[2];
#pragma unroll
    for (int i = 0; i < 2; ++i) { int R, C; stage_rc(tid * 16 + i * 8192, R, C); const int Rb = E.perm ? ((R & ~31) + perm32(R & 31)) : R;
        voffA[i] = (unsigned)(R * K + C) * 2u; voffB[i] = (unsigned)(Rb * K + C) * 2u; }
    const size_t kstep = (size_t)(BK * 2);
    const size_t hstep = (size_t)HALF * K * 2;
    const size_t tstep = 2 * hstep;
    const unsigned ldsw = (unsigned)wid * 1024u;
    const int aoff = lds_byte(wr * 64 + fr, fq * 8), boff = lds_byte(wc * 32 + fr, fq * 8);
#define PG8_SA(b, h) (((b) * 2 + (h)) * HTB)
#define PG8_SB(b, h) ((4 + (b) * 2 + (h)) * HTB)
#define PG8_STAGE(bufoff, gbase, voff) do { _Pragma("unroll") for (int _i = 0; _i < 2; ++_i) \
        __builtin_amdgcn_global_load_lds((const unsigned*)((const char*)(gbase) + (voff)[_i]), (LAS unsigned*)(lds + (bufoff) + ldsw + _i * 8192), 16, 0, 0); } while (0)
#define PG8_LDA(dst, b, h) do { _Pragma("unroll") for (int m = 0; m < 4; ++m) _Pragma("unroll") for (int k = 0; k < 2; ++k) dst[m][k] = *(const LAS bf16x8*)(lds + PG8_SA(b, h) + aoff + m * 2048 + k * 1024); } while (0)
#define PG8_LDB(dst, b, h) do { _Pragma("unroll") for (int n = 0; n < 2; ++n) _Pragma("unroll") for (int k = 0; k < 2; ++k) dst[n][k] = *(const LAS bf16x8*)(lds + PG8_SB(b, h) + boff + n * 2048 + k * 1024); } while (0)
#define PG8_MMA(ai, bj, At, Bt) do { __builtin_amdgcn_s_setprio(1); _Pragma("unroll") for (int m = 0; m < 4; ++m) _Pragma("unroll") for (int n = 0; n < 2; ++n) _Pragma("unroll") for (int k = 0; k < 2; ++k) \
        acc[ai][bj][m][n] = __builtin_amdgcn_mfma_f32_16x16x32_bf16(Bt[n][k], At[m][k], acc[ai][bj][m][n], 0, 0, 0); __builtin_amdgcn_s_setprio(0); } while (0)
#define PG8_WAIT_V(n) asm volatile("s_waitcnt vmcnt(" #n ")" ::: "memory")
#define PG8_WAIT_L(n) asm volatile("s_waitcnt lgkmcnt(" #n ")" ::: "memory")
#define PG8_BAR __builtin_amdgcn_s_barrier()
#define PG8_SCHED __builtin_amdgcn_sched_barrier(0)
    Unit cur, nxt; int ui = 0;
    if (!S.next(0, cur)) return;
    f32x4 acc[2][2][4][2];
#pragma unroll
    for (int a = 0; a < 2; ++a)
#pragma unroll
        for (int b = 0; b < 2; ++b)
#pragma unroll
            for (int m = 0; m < 4; ++m)
#pragma unroll
                for (int n = 0; n < 2; ++n) acc[a][b][m][n] = (f32x4){0.f, 0.f, 0.f, 0.f};
    bf16x8 At[4][2], B0[2][2], B1[2][2];
    const char* cA = (const char*)g.A + (size_t)cur.pm * tstep; const char* cB = (const char*)g.Bt + (size_t)cur.pn * tstep;
    if constexpr (SP2) {
        PG8_STAGE(PG8_SB(0, 0), cB, voffB); PG8_STAGE(PG8_SB(0, 1), cB + hstep, voffB); PG8_STAGE(PG8_SA(0, 0), cA, voffA); PG8_STAGE(PG8_SA(0, 1), cA + hstep, voffA);
        if (wr == 1) PG8_BAR;
        PG8_WAIT_V(2); PG8_BAR;
        PG8_STAGE(PG8_SB(1, 0), cB + kstep, voffB); PG8_STAGE(PG8_SA(1, 0), cA + kstep, voffA); PG8_STAGE(PG8_SB(1, 1), cB + hstep + kstep, voffB);
        PG8_WAIT_V(6); PG8_BAR;
    } else {
        PG8_STAGE(PG8_SB(0, 0), cB, voffB); PG8_STAGE(PG8_SA(0, 0), cA, voffA); PG8_STAGE(PG8_SB(0, 1), cB + hstep, voffB); PG8_STAGE(PG8_SA(0, 1), cA + hstep, voffA);
        if (wr == 1) PG8_BAR;
        PG8_WAIT_V(4); PG8_BAR;
        PG8_STAGE(PG8_SB(1, 0), cB + kstep, voffB); PG8_STAGE(PG8_SA(1, 0), cA + kstep, voffA); PG8_STAGE(PG8_SB(1, 1), cB + hstep + kstep, voffB);
        PG8_WAIT_V(6); PG8_BAR;
    }
    for (;;) {
        const bool has_next = S.next(ui + 1, nxt);
        const char* nA = has_next ? (const char*)g.A + (size_t)nxt.pm * tstep : cA; const char* nB = has_next ? (const char*)g.Bt + (size_t)nxt.pn * tstep : cB;
        for (int t = 0; t < nt; t += 2) {
            const bool last = (t == nt - 2);
            const char* a1 = cA + (size_t)(t + 1) * kstep;
            const char* a2 = last ? nA : cA + (size_t)(t + 2) * kstep; const char* b2 = last ? nB : cB + (size_t)(t + 2) * kstep;
            const char* a3 = a2 + kstep; const char* b3 = b2 + kstep;
            if constexpr (SP2) {
            PG8_LDB(B0, 0, 0); PG8_LDB(B1, 0, 1); PG8_SCHED; PG8_LDA(At, 0, 0); PG8_STAGE(PG8_SA(1, 1), a1 + hstep, voffA);
            PG8_WAIT_V(8); PG8_WAIT_L(0); PG8_BAR; PG8_MMA(0, 0, At, B0); PG8_MMA(0, 1, At, B1); PG8_BAR; PG8_SCHED;
            PG8_LDA(At, 0, 1); PG8_STAGE(PG8_SB(0, 0), b2, voffB); PG8_STAGE(PG8_SB(0, 1), b2 + hstep, voffB); PG8_STAGE(PG8_SA(0, 0), a2, voffA);
            PG8_WAIT_V(8); PG8_WAIT_L(0); PG8_BAR; PG8_MMA(1, 0, At, B0); PG8_MMA(1, 1, At, B1); PG8_BAR; PG8_SCHED;
            PG8_LDB(B0, 1, 0); PG8_LDB(B1, 1, 1); PG8_SCHED; PG8_LDA(At, 1, 0); PG8_STAGE(PG8_SA(0, 1), a2 + hstep, voffA);
            PG8_WAIT_V(8); PG8_WAIT_L(0); PG8_BAR; PG8_MMA(0, 0, At, B0); PG8_MMA(0, 1, At, B1); PG8_BAR; PG8_SCHED;
            PG8_LDA(At, 1, 1); PG8_STAGE(PG8_SB(1, 0), b3, voffB); PG8_STAGE(PG8_SB(1, 1), b3 + hstep, voffB); PG8_STAGE(PG8_SA(1, 0), a3, voffA);
            PG8_WAIT_V(8); PG8_WAIT_L(0); PG8_BAR; PG8_MMA(1, 0, At, B0); PG8_MMA(1, 1, At, B1); PG8_BAR; PG8_SCHED;
            } else {
            PG8_LDB(B0, 0, 0); PG8_SCHED; PG8_LDA(At, 0, 0); PG8_STAGE(PG8_SA(1, 1), a1 + hstep, voffA);
            PG8_WAIT_L(8); PG8_BAR; PG8_WAIT_L(0); PG8_MMA(0, 0, At, B0); PG8_BAR; PG8_SCHED;
            PG8_LDB(B1, 0, 1); PG8_STAGE(PG8_SB(0, 0), b2, voffB);
            PG8_BAR; PG8_WAIT_L(0); PG8_MMA(0, 1, At, B1); PG8_BAR;
            PG8_LDA(At, 0, 1); PG8_STAGE(PG8_SA(0, 0), a2, voffA);
            PG8_BAR; PG8_WAIT_L(0); PG8_MMA(1, 0, At, B0); PG8_BAR; PG8_SCHED;
            PG8_STAGE(PG8_SB(0, 1), b2 + hstep, voffB);
            PG8_WAIT_V(6); PG8_BAR; PG8_MMA(1, 1, At, B1); PG8_BAR;
            PG8_LDB(B0, 1, 0); PG8_SCHED; PG8_LDA(At, 1, 0); PG8_STAGE(PG8_SA(0, 1), a2 + hstep, voffA);
            PG8_WAIT_L(8); PG8_BAR; PG8_WAIT_L(0); PG8_MMA(0, 0, At, B0); PG8_BAR; PG8_SCHED;
            PG8_LDB(B1, 1, 1); PG8_STAGE(PG8_SB(1, 0), b3, voffB);
            PG8_BAR; PG8_WAIT_L(0); PG8_MMA(0, 1, At, B1); PG8_BAR;
            PG8_LDA(At, 1, 1); PG8_STAGE(PG8_SA(1, 0), a3, voffA);
            PG8_BAR; PG8_WAIT_L(0); PG8_MMA(1, 0, At, B0); PG8_BAR; PG8_SCHED;
            PG8_STAGE(PG8_SB(1, 1), b3 + hstep, voffB);
            PG8_WAIT_V(6); PG8_BAR; PG8_MMA(1, 1, At, B1); PG8_BAR;
            }
        }
        if constexpr (ALIGN_EPI) { if (wr == 0) PG8_BAR; }
        E(acc, cur, wr, wc, fr, fq);
        if (!has_next) break;
#pragma unroll
        for (int a = 0; a < 2; ++a)
#pragma unroll
            for (int b = 0; b < 2; ++b)
#pragma unroll
                for (int m = 0; m < 4; ++m)
#pragma unroll
                    for (int n = 0; n < 2; ++n) acc[a][b][m][n] = (f32x4){0.f, 0.f, 0.f, 0.f};
        cur = nxt; cA = nA; cB = nB; ++ui;
        if constexpr (ALIGN_EPI) { if (wr == 1) PG8_BAR; }
    }
    PG8_WAIT_V(0);
    if constexpr (!ALIGN_EPI) { if (wr == 0) PG8_BAR; }
    PG8_BAR;
#undef PG8_SA
#undef PG8_SB
#undef PG8_STAGE
#undef PG8_LDA
#undef PG8_LDB
#undef PG8_MMA
#undef PG8_WAIT_V
#undef PG8_WAIT_L
#undef PG8_BAR
#undef PG8_SCHED
}
}

struct EpiAny {
    int mode; bool perm;
    bf16_t* O; const float* xa; const float* xb; const float* modl; int goff; float* out;
    __device__ __forceinline__ void operator()(const f32x4 (&acc)[2][2][4][2], const pg8::Unit& u, int wr, int wc, int fr, int fq) const {
        const int row0 = u.pm * 256 + wr * 64 + fr;
        if (mode == 0) {
            const int col0 = u.pn * 256 + wc * 32 + 8 * fq;
#pragma unroll
            for (int ai = 0; ai < 2; ++ai)
#pragma unroll
                for (int m = 0; m < 4; ++m) { bf16_t* rowp = O + (size_t)(row0 + ai * 128 + m * 16) * INW;
#pragma unroll
                    for (int bj = 0; bj < 2; ++bj) { const int col = col0 + bj * 128;
                        if (col < INW) { const f32x4 v0 = acc[ai][bj][m][0], v1 = acc[ai][bj][m][1]; u32x4 w;
                            w.x = pg8::cvt_pk_bf16(v0[0], v0[1]); w.y = pg8::cvt_pk_bf16(v0[2], v0[3]); w.z = pg8::cvt_pk_bf16(v1[0], v1[1]); w.w = pg8::cvt_pk_bf16(v1[2], v1[3]);
                            *(u32x4*)(rowp + col) = w; } } }
        } else if (mode == 1) {
            const int col0 = u.pn * 256 + wc * 32 + 4 * fq;
            const float* gp = modl + mi_of(u.pm * 256) * 6144 + goff;
#pragma unroll
            for (int ai = 0; ai < 2; ++ai)
#pragma unroll
                for (int m = 0; m < 4; ++m) { const int row = row0 + ai * 128 + m * 16;
                    const float* xs = row < NPT ? xa + (size_t)row * D : xb + (size_t)(row - NPT) * D; float* o = out + (size_t)row * D;
#pragma unroll
                    for (int bj = 0; bj < 2; ++bj)
#pragma unroll
                        for (int n = 0; n < 2; ++n) { const int col = col0 + bj * 128 + n * 16;
                            const f32x4 xv = *(const f32x4*)(xs + col), gv = *(const f32x4*)(gp + col);
                            *(f32x4*)(o + col) = xv + gv * acc[ai][bj][m][n]; } }
        } else {
#pragma unroll
            for (int ai = 0; ai < 2; ++ai)
#pragma unroll
                for (int m = 0; m < 4; ++m) { bf16_t* rowp = O + (size_t)(row0 + ai * 128 + m * 16) * FF;
                    const int oc = u.pn * 128 + wc * 32 + 8 * fq;
                    float a[8];
#pragma unroll
                    for (int n = 0; n < 2; ++n) { const f32x4 gt = acc[ai][0][m][n], up = acc[ai][1][m][n];
#pragma unroll
                        for (int k = 0; k < 4; ++k) a[4 * n + k] = gt[k] * __builtin_amdgcn_rcpf(1.f + __expf(-gt[k])) * up[k]; }
                    u32x4 w; w.x = pg8::cvt_pk_bf16(a[0], a[1]); w.y = pg8::cvt_pk_bf16(a[2], a[3]); w.z = pg8::cvt_pk_bf16(a[4], a[5]); w.w = pg8::cvt_pk_bf16(a[6], a[7]);
                    *(u32x4*)(rowp + oc) = w; }
        }
    }
};

template <int MODE>
__device__ __forceinline__ void transpose_item(const float* W, int K, int N, int nblk, bf16_t* WT, float* scr, int item, int lane) {
    const int kb = item / nblk, nb = item % nblk, k0 = 64 * kb, n0 = 32 * nb;
    const int nn = n0 + (lane & 31);
#pragma unroll
    for (int i = 0; i < 32; ++i) { const int kk = 2 * i + (lane >> 5); scr[kk * 33 + (lane & 31)] = (nn < N) ? W[(size_t)(k0 + kk) * N + nn] : 0.f; }
    __builtin_amdgcn_fence(__ATOMIC_RELEASE, "wavefront"); asm volatile("s_waitcnt lgkmcnt(0)" ::: "memory");
    const int c = lane & 7;
#pragma unroll
    for (int j = 0; j < 4; ++j) { const int n = (lane >> 3) + 8 * j; const float* s = scr + (8 * c) * 33 + n;
        u32x4 o; o.x = pk2(s[0 * 33], s[1 * 33]); o.y = pk2(s[2 * 33], s[3 * 33]); o.z = pk2(s[4 * 33], s[5 * 33]); o.w = pk2(s[6 * 33], s[7 * 33]);
        int row;
        if (MODE == 0) row = n0 + n; else row = 256 * (n0 >> 7) + (n0 & 127) + n + (MODE == 2 ? 128 : 0);
        *(u32x4*)(WT + (size_t)row * K + k0 + 8 * c) = o; }
    asm volatile("s_waitcnt lgkmcnt(0)" ::: "memory");
}

__device__ __forceinline__ void phase0(const Params& P, unsigned char* lds, int tid_, int bid_, int G_) {
    const int tid = tid_, lane = tid & 63, wave = tid >> 6, G = G_;
    float* sc = (float*)lds;
    float* red = (float*)(lds + 20480);
    float* modw = (float*)(P.ws + WS_MOD);
    if ((int)bid_ < 192) {
        for (int i = tid; i < 5 * 1024; i += 512) { const int mi = i >> 10, k = i & 1023; const float c = mi == 0 ? P.in[6][k] : P.in[5][(mi - 1) * 1024 + k]; sc[i] = c / (1.f + expf(-c)); }
        __syncthreads();
        for (int item = bid_; item < 192; item += G) {
            const int l = item / 96, cgp = item % 96, col = cgp * 64 + (tid & 15) * 4, kr = tid >> 4;
            const float* aw = P.in[9] + (size_t)l * 1024 * 6144;
            float acc[5][4];
#pragma unroll
            for (int mi = 0; mi < 5; ++mi)
#pragma unroll
                for (int j = 0; j < 4; ++j) acc[mi][j] = 0.f;
#pragma unroll 4
            for (int kk = kr; kk < 1024; kk += 32) { const f32x4 w = *(const f32x4*)(aw + (size_t)kk * 6144 + col);
#pragma unroll
                for (int mi = 0; mi < 5; ++mi) { const float s = sc[mi * 1024 + kk]; acc[mi][0] += s * w[0]; acc[mi][1] += s * w[1]; acc[mi][2] += s * w[2]; acc[mi][3] += s * w[3]; } }
#pragma unroll
            for (int mi = 0; mi < 5; ++mi)
#pragma unroll
                for (int j = 0; j < 4; ++j) red[(kr * 5 + mi) * 64 + (tid & 15) * 4 + j] = acc[mi][j];
            __syncthreads();
            if (tid < 320) { const int mi = tid >> 6, c = tid & 63; float s = 0.f;
                for (int r = 0; r < 32; ++r) s += red[(r * 5 + mi) * 64 + c];
                modw[((size_t)l * 5 + mi) * 6144 + cgp * 64 + c] = s + P.in[10][(size_t)l * 6144 + cgp * 64 + c]; }
            __syncthreads();
        }
    }
    __syncthreads();
    float* scr = (float*)(lds + 65536 + wave * 8448);
    const int gw = bid_ * 8 + wave, NGW = G * 8;
    constexpr int I_IN = 16 * 88;
    for (int it = gw; it < I_IN; it += NGW) { const int l = 0, r = it;
        transpose_item<0>(P.in[7] + (size_t)l * 1024 * INW, 1024, INW, 88, (bf16_t*)(P.ws + WS_WIN) + (size_t)l * INP * 1024, scr, r, lane); }
}

__device__ __forceinline__ void norm_phase(const float* xa, const float* xb, const float* g, const float* modl, int sh_off, int sc_off, bf16_t* H, int tid_, int bid_, int G_) {
    const int lane = tid_ & 63, wave = tid_ >> 6;
    const int gw = bid_ * 8 + wave, NGW = G_ * 8;
    auto ld = [&](int row, f32x4 (&v)[4]) { const float* x = row < NPT ? xa + (size_t)row * D : xb + (size_t)(row - NPT) * D;
#pragma unroll
        for (int j = 0; j < 4; ++j) v[j] = *(const f32x4*)(x + 4 * lane + 256 * j); };
    f32x4 v[4], v1[4], v2[4];
#pragma unroll
    for (int j = 0; j < 4; ++j) { v[j] = (f32x4){0.f, 0.f, 0.f, 0.f}; v1[j] = v[j]; v2[j] = v[j]; }
    if (gw < NTOK) ld(gw, v);
    if (gw + NGW < NTOK) ld(gw + NGW, v1);
    for (int row = gw; row < NTOK; row += NGW) {
        if (row + 2 * NGW < NTOK) ld(row + 2 * NGW, v2);
        const float* md = modl + mi_of(row) * 6144;
        float ss = 0.f;
#pragma unroll
        for (int j = 0; j < 4; ++j) ss += (v[j][0] * v[j][0] + v[j][1] * v[j][1]) + (v[j][2] * v[j][2] + v[j][3] * v[j][3]);
#pragma unroll
        for (int o = 1; o < 64; o <<= 1) ss += shx(ss, o, lane);
        const float rstd = rsqrtf(ss * (1.f / D) + EPS);
#pragma unroll
        for (int j = 0; j < 4; ++j) { const int col = 4 * lane + 256 * j;
            const f32x4 gg = *(const f32x4*)(g + col), scv = *(const f32x4*)(md + sc_off + col), shv = *(const f32x4*)(md + sh_off + col);
            f32x4 h = v[j] * rstd * gg * (scv + 1.f) + shv;
            u32x2 w; w.x = pk2(h[0], h[1]); w.y = pk2(h[2], h[3]);
            *(u32x2*)(H + (size_t)row * D + col) = w; }
#pragma unroll
        for (int j = 0; j < 4; ++j) { v[j] = v1[j]; v1[j] = v2[j]; }
    }
}

__device__ __forceinline__ void prep_rows(const Params& P, int l, unsigned char* lds, int tid_, int bid_, int G_) {
    const int tid = tid_, lane = tid & 63, wave = tid >> 6;
    float* tab = (float*)lds;
    for (int i = tid; i < 1024; i += 512) { const int pos = i >> 4, k = i & 15; const float inv = exp2f(-(float)k * (13.287712379549449f / 16.f)); float s, c; sincosf((float)pos * inv, &s, &c); tab[2 * i] = c; tab[2 * i + 1] = s; }
    __syncthreads();
    {
        bf16_t* ck = (bf16_t*)(P.ws + WS_CK); bf16_t* cv = (bf16_t*)(P.ws + WS_CV);
        for (int i = (bid_ * 512 + tid) * 8; i < 4 * 512 * 128; i += G_ * 512 * 8) { const int sq_ = i >> 16, rem = i & 65535;
            const size_t src_i = ((size_t)(sq_ * 2 + l) << 16) + rem;
            const f32x4 a = *(const f32x4*)(P.in[2] + src_i), b2 = *(const f32x4*)(P.in[2] + src_i + 4), c = *(const f32x4*)(P.in[3] + src_i), d = *(const f32x4*)(P.in[3] + src_i + 4);
            u32x4 w; w.x = pk2(a[0], a[1]); w.y = pk2(a[2], a[3]); w.z = pk2(b2[0], b2[1]); w.w = pk2(b2[2], b2[3]); *(u32x4*)(ck + i) = w;
            w.x = pk2(c[0], c[1]); w.y = pk2(c[2], c[3]); w.z = pk2(d[0], d[1]); w.w = pk2(d[2], d[3]); *(u32x4*)(cv + i) = w; }
    }
    bf16_t* PROJ = (bf16_t*)(P.ws + WS_PROJ); bf16_t* MIX = (bf16_t*)(P.ws + WS_ABUF);
    const float* qg = P.in[15] + l * 64; const float* kg = P.in[16] + l * 64; const float* cw = P.in[13] + (size_t)l * 3 * 256;
    const int gw = bid_ * 8 + wave, NGW = G_ * 8;
    struct PrepRaw { u32x4 q, k, v; u32x2 cc[3], hh[3], bb; };
    auto prep_load = [&](int row, PrepRaw& R) {
        const bool sample = row >= NPT; const int t = sample ? ((row - NPT) & 4095) : (row & 255); const int n = sample ? 4096 : 256;
        const bf16_t* pr = PROJ + (size_t)row * INW; const int c4 = lane * 4;
        R.q = *(const u32x4*)(pr + 768 + lane * 8);
        R.k = (u32x4){0u, 0u, 0u, 0u}; R.v = (u32x4){0u, 0u, 0u, 0u};
        if (lane < 16) { R.k = *(const u32x4*)(pr + 1280 + lane * 8); if (!sample) R.v = *(const u32x4*)(pr + 1408 + lane * 8); }
#pragma unroll
        for (int j = 0; j < 3; ++j) { const int tt = t + j - 1; R.cc[j] = (u32x2){0u, 0u}; R.hh[j] = (u32x2){0u, 0u};
            if (tt >= 0 && tt < n) { const bf16_t* q = pr + (ptrdiff_t)(j - 1) * INW; R.cc[j] = *(const u32x2*)(q + 256 + c4); R.hh[j] = *(const u32x2*)(q + 512 + c4); } }
        R.bb = *(const u32x2*)(pr + c4);
    };
    PrepRaw Rc;
    if (gw < NTOK) prep_load(gw, Rc);
    for (int row = gw; row < NTOK; row += NGW) {
        PrepRaw Rn = Rc;
        if (row + NGW < NTOK) prep_load(row + NGW, Rn);
        const bool sample = row >= NPT; const int t = sample ? ((row - NPT) & 4095) : (row & 255);
        bf16_t* pr = PROJ + (size_t)row * INW;
        const int d0 = (lane & 7) * 8;
#pragma unroll
        for (int which = 0; which < 2; ++which) {
            const bool act = which == 0 || lane < 16;
            bf16_t* p = pr + (which == 0 ? 768 : 1280) + lane * 8;
            float x[8]; unpack8(which == 0 ? Rc.q : Rc.k, x);
            float ss = 0.f;
#pragma unroll
            for (int e = 0; e < 8; ++e) ss += x[e] * x[e];
            ss += shx(ss, 1, lane); ss += shx(ss, 2, lane); ss += shx(ss, 4, lane);
            const float rs = rsqrtf(ss * (1.f / 64.f) + EPS);
            const float* gp = which == 0 ? qg : kg;
#pragma unroll
            for (int e = 0; e < 8; ++e) x[e] = x[e] * rs * gp[d0 + e];
            if (which == 1 && !sample && act) { float* ok = P.out + OUT_K + ((size_t)((row >> 8) * 2 + l) * 256 + t) * 128 + lane * 8;
                *(f32x4*)ok = (f32x4){x[0], x[1], x[2], x[3]}; *(f32x4*)(ok + 4) = (f32x4){x[4], x[5], x[6], x[7]}; }
            if (sample) {
                const int half = d0 >> 5, part = (d0 >> 4) & 1, i0 = d0 & 15, pos = half ? (t & 63) : (t >> 6);
#pragma unroll
                for (int e = 0; e < 8; ++e) { const float pt = shx(x[e], 2, lane); const float c = tab[2 * (pos * 16 + i0 + e)], s = tab[2 * (pos * 16 + i0 + e) + 1];
                    x[e] = part == 0 ? x[e] * c - pt * s : x[e] * c + pt * s; }
            }
            if (which == 0) {
#pragma unroll
                for (int e = 0; e < 8; ++e) x[e] *= 0.125f * LOG2E;
            }
            if (act) *(u32x4*)p = pack8(x);
        }
        if (!sample && lane < 16) { float x[8]; unpack8(Rc.v, x);
            float* ov = P.out + OUT_V + ((size_t)((row >> 8) * 2 + l) * 256 + t) * 128 + lane * 8;
            *(f32x4*)ov = (f32x4){x[0], x[1], x[2], x[3]}; *(f32x4*)(ov + 4) = (f32x4){x[4], x[5], x[6], x[7]}; }
        {
            const int c4 = lane * 4; float acc[4] = {0.f, 0.f, 0.f, 0.f};
#pragma unroll
            for (int j = 0; j < 3; ++j) { const u32x2 cc = Rc.cc[j], hh = Rc.hh[j];
                const f32x4 w = *(const f32x4*)(cw + j * 256 + c4);
                acc[0] += w[0] * bf_lo(cc.x) * bf_lo(hh.x); acc[1] += w[1] * bf_hi(cc.x) * bf_hi(hh.x); acc[2] += w[2] * bf_lo(cc.y) * bf_lo(hh.y); acc[3] += w[3] * bf_hi(cc.y) * bf_hi(hh.y); }
            const u32x2 bb = Rc.bb;
            u32x2 w; w.x = pk2(acc[0] * bf_lo(bb.x), acc[1] * bf_hi(bb.x)); w.y = pk2(acc[2] * bf_lo(bb.y), acc[3] * bf_hi(bb.y));
            *(u32x2*)(MIX + (size_t)row * D + c4) = w;
        }
        Rc = Rn;
    }
    __syncthreads();
}

template <int J> __device__ __forceinline__ void solve_cols(float (&x)[32], const float* lrow) {
    if constexpr (J < 63) {
        const float xj = __int_as_float(__builtin_amdgcn_update_dpp(0, __float_as_int(x[J >> 1]), (J & 1) ? 0xF5 : 0xA0, 0xf, 0xf, false));
        constexpr int R0 = ((J + 1) / 2) / 4;
#pragma unroll
        for (int r4 = R0; r4 < 8; ++r4) { const f32x4 Lv = *(const f32x4*)(lrow + J * 68 + 4 * r4);
            x[4 * r4 + 0] -= Lv[0] * xj; x[4 * r4 + 1] -= Lv[1] * xj; x[4 * r4 + 2] -= Lv[2] * xj; x[4 * r4 + 3] -= Lv[3] * xj; }
        asm volatile("" : "+v"(x[0]), "+v"(x[1]), "+v"(x[2]), "+v"(x[3]), "+v"(x[4]), "+v"(x[5]), "+v"(x[6]), "+v"(x[7]), "+v"(x[8]), "+v"(x[9]), "+v"(x[10]), "+v"(x[11]), "+v"(x[12]), "+v"(x[13]), "+v"(x[14]), "+v"(x[15]));
        asm volatile("" : "+v"(x[16]), "+v"(x[17]), "+v"(x[18]), "+v"(x[19]), "+v"(x[20]), "+v"(x[21]), "+v"(x[22]), "+v"(x[23]), "+v"(x[24]), "+v"(x[25]), "+v"(x[26]), "+v"(x[27]), "+v"(x[28]), "+v"(x[29]), "+v"(x[30]), "+v"(x[31]));
        solve_cols<J + 1>(x, lrow);
    }
}
constexpr int DN_GROUP = 66560;
__device__ __forceinline__ void dn_chunk_item(const Params& P, int l, int item, unsigned char* lds, int tid_) {
    asm volatile("" : "+v"(tid_));
    const int tid = tid_, dir = tid >> 8, tg = tid & 255, wg = (tid >> 6) & 3, lane = tid & 63, fr = lane & 15, fq = lane >> 4;
    int seq, c, h, n, rowbase, slot;
    if (item < 256) { seq = item >> 4; c = (item >> 2) & 3; h = item & 3; n = 256; rowbase = seq * 256; slot = (seq * 8 + h * 2 + dir) * 4 + c; }
    else { const int it = item - 256; seq = it >> 8; c = (it >> 2) & 63; h = it & 3; n = 4096; rowbase = NPT + seq * 4096; slot = 512 + (seq * 8 + h * 2 + dir) * 64 + c; }
    unsigned char* L = lds + dir * DN_GROUP;
    bf16_t* sq = (bf16_t*)L; bf16_t* sk = sq + 64 * 72; bf16_t* sv = sk + 64 * 72; bf16_t* skT = sv + 64 * 72; bf16_t* sA = skT + 64 * 72;
    float* sL = (float*)(L + 46080); bf16_t* uT = (bf16_t*)(L + 46080); bf16_t* wT = uT + 64 * 72;
    float* sgc = (float*)(L + 46080 + 18432); float* sbeta = sgc + 64; float* sbe = sgc + 128; float* segl = sgc + 192; float* seg = sgc + 256;
    const bf16_t* PROJ = (const bf16_t*)(P.ws + WS_PROJ);
    const int r = tg >> 2, dq = (tg & 3) * 16;
    const int p = dir == 0 ? 64 * c + r : n - 1 - (64 * c + r);
    const bf16_t* pr = PROJ + (size_t)(rowbase + p) * INW;
    u32x4 raw[3][3][2];
#pragma unroll
    for (int mat = 0; mat < 3; ++mat)
#pragma unroll
        for (int j = 0; j < 3; ++j) { const int pp = p + j - 1; const bf16_t* q = pr + (ptrdiff_t)(j - 1) * INW + 1536 + mat * 256 + h * 64 + dq;
            if (pp >= 0 && pp < n) { raw[mat][j][0] = *(const u32x4*)q; raw[mat][j][1] = *(const u32x4*)(q + 8); }
            else { raw[mat][j][0] = (u32x4){0u, 0u, 0u, 0u}; raw[mat][j][1] = (u32x4){0u, 0u, 0u, 0u}; } }
    float beta_r, egl_r;
    {
        const int pg = dir == 0 ? 64 * c + lane : n - 1 - (64 * c + lane);
        const bf16_t* prg = PROJ + (size_t)(rowbase + pg) * INW;
        const float a = bf2f(prg[2560 + dir * 4 + h]), bb = bf2f(prg[2568 + dir * 4 + h]);
        const float Aexp = expf(P.in[18][l * 8 + dir * 4 + h]), dtb = P.in[19][l * 8 + dir * 4 + h];
        const float xx = a + dtb; const float sp = xx > 20.f ? xx : log1pf(expf(xx));
        float gcum = -Aexp * sp;
#pragma unroll
        for (int o = 1; o < 64; o <<= 1) { const float tt = shl_(gcum, (lane - o) & 63, lane); if (lane >= o) gcum += tt; }
        const float gl = shl_(gcum, 63, lane); const float beta = __builtin_amdgcn_rcpf(1.f + __expf(-bb)); const float egl = __expf(gl - gcum);
        if (wg == 0) { sgc[lane] = gcum; sbeta[lane] = beta; const float eg_ = __expf(gcum); sbe[lane] = beta * eg_; segl[lane] = egl; seg[lane] = eg_;
            if (lane == 63) ((float*)(P.ws + WS_DNG))[slot] = __expf(gl); }
        beta_r = shl_(beta, r, lane); egl_r = shl_(egl, r, lane);
    }
    {
#pragma unroll
        for (int mat = 0; mat < 3; ++mat) {
            const int ch0 = mat * 256 + h * 64 + dq;
            const float* cw = P.in[14] + (size_t)l * 3 * 768 + ch0;
            float x[16];
#pragma unroll
            for (int e = 0; e < 16; ++e) x[e] = 0.f;
#pragma unroll
            for (int j = 0; j < 3; ++j) { float v[16]; unpack8(raw[mat][j][0], v); unpack8(raw[mat][j][1], v + 8);
#pragma unroll
                for (int e4 = 0; e4 < 4; ++e4) { const f32x4 w = *(const f32x4*)(cw + j * 768 + 4 * e4);
                    x[4 * e4 + 0] += w[0] * v[4 * e4 + 0]; x[4 * e4 + 1] += w[1] * v[4 * e4 + 1]; x[4 * e4 + 2] += w[2] * v[4 * e4 + 2]; x[4 * e4 + 3] += w[3] * v[4 * e4 + 3]; } }
            float ss = 0.f;
#pragma unroll
            for (int e = 0; e < 16; ++e) { x[e] = x[e] * __builtin_amdgcn_rcpf(1.f + __expf(-x[e])); ss += x[e] * x[e]; }
            if (mat < 2) { ss += shx(ss, 1, lane); ss += shx(ss, 2, lane); const float rs = rsqrtf(ss + EPS) * (mat == 0 ? 0.125f : 1.f);
#pragma unroll
                for (int e = 0; e < 16; ++e) x[e] *= rs; }
            bf16_t* dst = sq + mat * (64 * 72) + r * 72 + dq;
            *(u32x4*)dst = pack8(x); *(u32x4*)(dst + 8) = pack8(x + 8);
            if (mat == 1) {
                float y[16];
#pragma unroll
                for (int e = 0; e < 16; ++e) y[e] = x[e] * beta_r;
                *(u32x4*)(sA + r * 72 + dq) = pack8(y); *(u32x4*)(sA + r * 72 + dq + 8) = pack8(y + 8);
#pragma unroll
                for (int e = 0; e < 16; e += 2) { const unsigned pw = pk2(x[e] * egl_r, x[e + 1] * egl_r); skT[(dq + e) * 72 + r] = (bf16_t)(pw & 0xffffu); skT[(dq + e + 1) * 72 + r] = (bf16_t)(pw >> 16); }
            }
        }
    }
    __syncthreads();
    {
        f32x4 kk[4], qk[4];
        bf16x8 kf0[2], qf[2];
#pragma unroll
        for (int ks = 0; ks < 2; ++ks) { kf0[ks] = *(const bf16x8*)(sk + (16 * wg + fr) * 72 + 32 * ks + 8 * fq); qf[ks] = *(const bf16x8*)(sq + (16 * wg + fr) * 72 + 32 * ks + 8 * fq); }
#pragma unroll
        for (int nb = 0; nb < 4; ++nb) { kk[nb] = (f32x4){0.f, 0.f, 0.f, 0.f}; qk[nb] = (f32x4){0.f, 0.f, 0.f, 0.f};
#pragma unroll
            for (int ks = 0; ks < 2; ++ks) { const bf16x8 kbv = *(const bf16x8*)(sA + (16 * nb + fr) * 72 + 32 * ks + 8 * fq), kv = *(const bf16x8*)(sk + (16 * nb + fr) * 72 + 32 * ks + 8 * fq);
                kk[nb] = mfma16(kf0[ks], kbv, kk[nb]); qk[nb] = mfma16(qf[ks], kv, qk[nb]); } }
        __syncthreads();
#pragma unroll
        for (int nb = 0; nb < 4; ++nb)
#pragma unroll
            for (int jj = 0; jj < 4; ++jj) { const int a = 16 * wg + 4 * fq + jj, bb = 16 * nb + fr;
                const float ga = sgc[a], gb = sgc[bb];
                const float ed = __expf(bb > a ? gb - ga : ga - gb);
                const float decL = bb > a ? ed : 0.f;
                const float decA = a >= bb ? ed : 0.f;
                sL[a * 68 + (bb & 1) * 32 + (bb >> 1)] = kk[nb][jj] * decL;
                sA[a * 72 + bb] = (bf16_t)(pk2(qk[nb][jj] * decA, 0.f) & 0xffffu); }
    }
    __syncthreads();
    {
        const int col = tg >> 1, par = tg & 1;
        const bf16_t* src = (col < 64 ? sv + col : sk + (col - 64)) + par * 72;
        const float* scl = (col < 64 ? sbeta : sbe) + par;
        float x[32];
#pragma unroll
        for (int r = 0; r < 32; ++r) x[r] = bf2f(src[2 * r * 72]) * scl[2 * r];
        solve_cols<0>(x, sL + 32 * par);
        __syncthreads();
        bf16_t* dst = (col < 64 ? uT + col * 72 : wT + (col - 64) * 72) + 32 * par;
        unsigned w[16];
#pragma unroll
        for (int k = 0; k < 32; ++k) {
            const float other = __int_as_float(__builtin_amdgcn_update_dpp(0, __float_as_int(x[k]), 0xB1, 0xf, 0xf, false));
            if (k < 16) { if (par == 0) w[k] = pk2(x[k], other); } else { if (par == 1) w[k - 16] = pk2(other, x[k]); }
        }
#pragma unroll
        for (int e4 = 0; e4 < 4; ++e4) *(u32x4*)(dst + 8 * e4) = (u32x4){w[4 * e4], w[4 * e4 + 1], w[4 * e4 + 2], w[4 * e4 + 3]};
    }
    __syncthreads();
    {
        bf16x8 af[2], kf[2];
#pragma unroll
        for (int ks = 0; ks < 2; ++ks) { af[ks] = *(const bf16x8*)(sA + (16 * wg + fr) * 72 + 32 * ks + 8 * fq); kf[ks] = *(const bf16x8*)(skT + (16 * wg + fr) * 72 + 32 * ks + 8 * fq); }
        bf16_t* gM = (bf16_t*)(P.ws + WS_DN) + (size_t)slot * 4096; bf16_t* gB = (bf16_t*)(P.ws + WS_DN + DN_MAT) + (size_t)slot * 4096; bf16_t* gQ = (bf16_t*)(P.ws + WS_DN + 2 * DN_MAT) + (size_t)slot * 4096;
        const int irow = 16 * wg + fr;
        const int pi = dir == 0 ? 64 * c + irow : n - 1 - (64 * c + irow);
        bf16_t* gO = (bf16_t*)(P.ws + WS_OFB) + ((size_t)dir * NTOK + rowbase + pi) * 256 + h * 64;
        const float eg_i = seg[irow];
#pragma unroll
        for (int nb = 0; nb < 4; ++nb) {
            f32x4 aw = (f32x4){0.f, 0.f, 0.f, 0.f}, au = aw, mx = aw, bx = aw;
#pragma unroll
            for (int ks = 0; ks < 2; ++ks) { const bf16x8 wf = *(const bf16x8*)(wT + (16 * nb + fr) * 72 + 32 * ks + 8 * fq), uf = *(const bf16x8*)(uT + (16 * nb + fr) * 72 + 32 * ks + 8 * fq);
                aw = mfma16(wf, af[ks], aw); au = mfma16(uf, af[ks], au); mx = mfma16(wf, kf[ks], mx); bx = mfma16(kf[ks], uf, bx); }
            const int cc = 16 * nb + 4 * fq;
            u32x2 w;
            const int fo = (((wg * 2 + (cc >> 5)) * 64 + ((cc & 31) >> 3) * 16 + fr) * 8 + (cc & 7));
            w.x = pk2(-mx[0], -mx[1]); w.y = pk2(-mx[2], -mx[3]); *(u32x2*)(gM + fo) = w;
            w.x = pk2(bx[0], bx[1]); w.y = pk2(bx[2], bx[3]); *(u32x2*)(gB + ((nb * 4 + wg) * 64 + fq * 16 + fr) * 4) = w;
            const u32x2 qq = *(const u32x2*)(sq + irow * 72 + cc);
            w.x = pk2(bf_lo(qq.x) * eg_i - aw[0], bf_hi(qq.x) * eg_i - aw[1]); w.y = pk2(bf_lo(qq.y) * eg_i - aw[2], bf_hi(qq.y) * eg_i - aw[3]); *(u32x2*)(gQ + fo) = w;
            w.x = pk2(au[0], au[1]); w.y = pk2(au[2], au[3]); *(u32x2*)(gO + cc) = w;
        }
    }
    lds_barrier();
}

template <int NT = 2, bool DRY = false> __device__ __forceinline__ void dn_scan_chain(const Params& P, int l, int chain, int vhalf, unsigned char* lds, int tid_) {
    const int tid = tid_, w = tid >> 6, lane = tid & 63, fr = lane & 15, fq = lane >> 4, rb = w >> 1, cb0 = NT == 2 ? (w & 1) * 2 : vhalf * 2 + (w & 1);
    int seq, h, dir, n, nc, rowbase, slot0; bool sample;
    if (chain < 128) { seq = chain >> 3; h = (chain >> 1) & 3; dir = chain & 1; n = 256; nc = 4; rowbase = seq * 256; slot0 = chain * 4; sample = false; }
    else { const int cc = chain - 128; seq = cc >> 3; h = (cc >> 1) & 3; dir = cc & 1; n = 4096; nc = 64; rowbase = NPT + seq * 4096; slot0 = 512 + cc * 64; sample = true; }
    bf16_t* ST = (bf16_t*)lds;
    const size_t sidx = ((size_t)((seq * 2 + l) * 2 + dir) * 4 + h) * 4096;
    f32x4 S[NT];
#pragma unroll
    for (int t = 0; t < NT; ++t) { const int v = 16 * (cb0 + t) + fr;
#pragma unroll
        for (int jj = 0; jj < 4; ++jj) S[t][jj] = sample ? P.in[4][sidx + (16 * rb + 4 * fq + jj) * 64 + v] : 0.f;
        u32x2 wv; wv.x = pk2(S[t][0], S[t][1]); wv.y = pk2(S[t][2], S[t][3]); *(u32x2*)(ST + v * 72 + 16 * rb + 4 * fq) = wv; }
    __syncthreads();
    const bf16_t* gMb = (const bf16_t*)(P.ws + WS_DN); const bf16_t* gBb = (const bf16_t*)(P.ws + WS_DN + DN_MAT); const bf16_t* gQb = (const bf16_t*)(P.ws + WS_DN + 2 * DN_MAT);
    const float* gG = (const float*)(P.ws + WS_DNG);
    bf16_t* OFB = (bf16_t*)(P.ws + WS_OFB) + (size_t)dir * NTOK * 256;
    auto load_step = [&](int c, bf16x8 (&M_)[2], bf16x8 (&Q_)[2], float& eg_, u32x2 (&bt_)[NT], u32x2 (&o0_)[NT]) {
        const int slot = slot0 + c;
        const bf16_t* gM = gMb + (size_t)slot * 4096; const bf16_t* gB = gBb + (size_t)slot * 4096; const bf16_t* gQ = gQb + (size_t)slot * 4096;
#pragma unroll
        for (int ks = 0; ks < 2; ++ks) { M_[ks] = *(const bf16x8*)(gM + ((rb * 2 + ks) * 64 + lane) * 8); Q_[ks] = *(const bf16x8*)(gQ + ((rb * 2 + ks) * 64 + lane) * 8); }
        eg_ = gG[slot];
        const int il = 16 * rb + fr; const int pi = dir == 0 ? 64 * c + il : n - 1 - (64 * c + il);
        const bf16_t* orow = OFB + (size_t)(rowbase + pi) * 256 + h * 64;
#pragma unroll
        for (int t = 0; t < NT; ++t) { const int cb = cb0 + t; bt_[t] = *(const u32x2*)(gB + ((cb * 4 + rb) * 64 + lane) * 4); o0_[t] = *(const u32x2*)(orow + 16 * cb + 4 * fq); }
    };
    bf16x8 Mr[4][2], Qr[4][2]; float er[4]; u32x2 br[4][NT], orr[4][NT];
#pragma unroll
    for (int k = 0; k < 4; ++k) load_step(k, Mr[k], Qr[k], er[k], br[k], orr[k]);
    for (int c0 = 0; c0 < nc; c0 += 4) {
#pragma unroll
        for (int k = 0; k < 4; ++k) {
            const int c = c0 + k, cur = k & 1;
            const int il = 16 * rb + fr; const int pi = dir == 0 ? 64 * c + il : n - 1 - (64 * c + il);
            bf16_t* orow = OFB + (size_t)(rowbase + pi) * 256 + h * 64;
            const float egc = er[k];
#pragma unroll
            for (int t = 0; t < NT; ++t) { const int cb = cb0 + t;
                const u32x2 bt = br[k][t], o0 = orr[k][t];
                bf16x8 Sf[2];
#pragma unroll
                for (int ks = 0; ks < 2; ++ks) Sf[ks] = *(const bf16x8*)(ST + cur * 64 * 72 + (16 * cb + fr) * 72 + 32 * ks + 8 * fq);
                f32x4 o = (f32x4){bf_lo(o0.x), bf_hi(o0.x), bf_lo(o0.y), bf_hi(o0.y)};
                o = mfma16(Sf[0], Qr[k][0], o); o = mfma16(Sf[1], Qr[k][1], o);
                u32x2 wv; wv.x = pk2(o[0], o[1]); wv.y = pk2(o[2], o[3]); if (!DRY || o[0] == 1234.5f) *(u32x2*)(orow + 16 * cb + 4 * fq) = wv;
                f32x4 s = S[t] * egc + (f32x4){bf_lo(bt.x), bf_hi(bt.x), bf_lo(bt.y), bf_hi(bt.y)};
                s = mfma16(Mr[k][0], Sf[0], s); s = mfma16(Mr[k][1], Sf[1], s);
                S[t] = s;
                wv.x = pk2(s[0], s[1]); wv.y = pk2(s[2], s[3]); *(u32x2*)(ST + (cur ^ 1) * 64 * 72 + (16 * cb + fr) * 72 + 16 * rb + 4 * fq) = wv;
            }
            if (c + 4 < nc) load_step(c + 4, Mr[k], Qr[k], er[k], br[k], orr[k]);
            lds_barrier();
        }
    }
    if (!sample && !DRY) {
#pragma unroll
        for (int t = 0; t < NT; ++t) { const int v = 16 * (cb0 + t) + fr;
#pragma unroll
            for (int jj = 0; jj < 4; ++jj) P.out[OUT_S + sidx + (16 * rb + 4 * fq + jj) * 64 + v] = S[t][jj]; }
    }
    __syncthreads();
}

__device__ __forceinline__ void attn_unit(const Params& P, int l, int unit, unsigned char* lds, int tid_) {
    const int tid = tid_, w = tid >> 6, lane = tid & 63, fr = lane & 15, fq = lane >> 4;
    bool sample; int seq, kvh, qb;
    if (unit < 512) { sample = true; seq = unit >> 7; kvh = (unit >> 6) & 1; qb = unit & 63; }
    else { const int u2 = unit - 512; sample = false; seq = u2 >> 3; kvh = (u2 >> 2) & 1; qb = u2 & 3; }
    const int g = w >> 1, hq = kvh * 4 + g, q0 = qb * 64, qoff = (w & 1) * 32;
    const int rowbase = sample ? NPT + seq * 4096 : seq * 256, n = sample ? 4096 : 256;
    const bf16_t* PROJ = (const bf16_t*)(P.ws + WS_PROJ);
    bf16_t* Ks = (bf16_t*)lds;
    bf16_t* VT = Ks + 2 * 64 * 72;
    bf16x8 Qf[2][2];
#pragma unroll
    for (int qk = 0; qk < 2; ++qk)
#pragma unroll
        for (int ks = 0; ks < 2; ++ks) Qf[qk][ks] = *(const bf16x8*)(PROJ + (size_t)(rowbase + q0 + qoff + 16 * qk + fr) * INW + 768 + hq * 64 + 32 * ks + 8 * fq);
    const float sinkv = P.in[17][l * 8 + hq] * LOG2E;
    float mrun[2] = {sinkv, sinkv}, lsum[2] = {fq == 0 ? 1.f : 0.f, fq == 0 ? 1.f : 0.f};
    f32x4 O[2][4];
#pragma unroll
    for (int a = 0; a < 2; ++a)
#pragma unroll
        for (int b = 0; b < 4; ++b) O[a][b] = (f32x4){0.f, 0.f, 0.f, 0.f};
    int jlo = 0, jhi = 0, ntile;
    if (sample) { jlo = q0 >= 128 ? 0 : (128 - q0) / 64; jhi = (n + 64 - q0) / 64; if (jhi > 4) jhi = 4; ntile = 8 + (jhi - jlo + 1); } else ntile = 4;
    const int key = tid >> 3, dch = (tid & 7) * 8;
    auto load_tile = [&](int t, u32x4& kreg, u32x4& vreg) {
        if (sample && t < 8) {
            const size_t ci = ((size_t)(seq * 512 + 64 * t + key)) * 128 + kvh * 64 + dch;
            kreg = *(const u32x4*)((const bf16_t*)(P.ws + WS_CK) + ci); vreg = *(const u32x4*)((const bf16_t*)(P.ws + WS_CV) + ci);
        } else {
            const int ts = sample ? q0 - 128 + 64 * (jlo + t - 8) : 64 * t;
            const bf16_t* pr = PROJ + (size_t)(rowbase + ts + key) * INW + kvh * 64 + dch;
            kreg = *(const u32x4*)(pr + 1280); vreg = *(const u32x4*)(pr + 1408);
        }
    };
    auto store_tile = [&](int buf, const u32x4& kreg, const u32x4& vreg) {
        *(u32x4*)(Ks + buf * 64 * 72 + key * 72 + dch) = kreg;
        *(u32x4*)(VT + buf * 64 * 72 + key * 72 + dch) = vreg;
    };
    u32x4 kr[3], vr[3];
    load_tile(0, kr[0], vr[0]); store_tile(0, kr[0], vr[0]);
#pragma unroll
    for (int k = 0; k < 3; ++k) if (k + 1 < ntile) load_tile(k + 1, kr[k], vr[k]);
    lds_barrier();
    for (int t0 = 0; t0 < ntile; t0 += 3) {
#pragma unroll
        for (int k = 0; k < 3; ++k) {
            const int t = t0 + k;
            if (t < ntile) {
        const int cur = t & 1;
        const bf16_t* Kc = Ks + cur * 64 * 72; const bf16_t* Vc = VT + cur * 64 * 72;
        const int jw = jlo + t - 8;
        const bool masked = sample && t >= 8 && (jw == 0 || jw == 4);
        const int ts = masked ? q0 - 128 + 64 * jw : 0;
        f32x4 s[2][4];
#pragma unroll
        for (int kb = 0; kb < 4; ++kb) {
            bf16x8 kf[2];
#pragma unroll
            for (int ks = 0; ks < 2; ++ks) kf[ks] = *(const bf16x8*)(Kc + (16 * kb + fr) * 72 + 32 * ks + 8 * fq);
#pragma unroll
            for (int qk = 0; qk < 2; ++qk) { f32x4 a = (f32x4){0.f, 0.f, 0.f, 0.f}; a = mfma16(kf[0], Qf[qk][0], a); a = mfma16(kf[1], Qf[qk][1], a); s[qk][kb] = a; }
        }
        bf16x8 pf[2][2];
#pragma unroll
        for (int qk = 0; qk < 2; ++qk) {
            if (masked) { const int qp = q0 + qoff + 16 * qk + fr;
#pragma unroll
                for (int kb = 0; kb < 4; ++kb)
#pragma unroll
                    for (int jj = 0; jj < 4; ++jj) { const int kp = ts + 16 * kb + 4 * fq + jj; const int df = qp - kp; if (df > 128 || df < -128) s[qk][kb][jj] = -1e30f; } }
            float mx = s[qk][0][0];
#pragma unroll
            for (int kb = 0; kb < 4; ++kb)
#pragma unroll
                for (int jj = 0; jj < 4; ++jj) mx = fmaxf(mx, s[qk][kb][jj]);
            mx = fmaxf(mx, shx(mx, 16, lane)); mx = fmaxf(mx, shx(mx, 32, lane));
            const float mnew = fmaxf(mrun[qk], mx); const float alpha = __builtin_amdgcn_exp2f(mrun[qk] - mnew); mrun[qk] = mnew;
            float ps = 0.f;
#pragma unroll
            for (int kb = 0; kb < 4; ++kb)
#pragma unroll
                for (int jj = 0; jj < 4; ++jj) { const float p = __builtin_amdgcn_exp2f(s[qk][kb][jj] - mnew); s[qk][kb][jj] = p; ps += p; }
            lsum[qk] = lsum[qk] * alpha + ps;
            if (__builtin_amdgcn_ballot_w64(alpha != 1.f) != 0ull) {
#pragma unroll
                for (int db = 0; db < 4; ++db) O[qk][db] = O[qk][db] * alpha; }
#pragma unroll
            for (int m2 = 0; m2 < 2; ++m2) { u32x4 pw; pw.x = pk2(s[qk][2 * m2][0], s[qk][2 * m2][1]); pw.y = pk2(s[qk][2 * m2][2], s[qk][2 * m2][3]);
                pw.z = pk2(s[qk][2 * m2 + 1][0], s[qk][2 * m2 + 1][1]); pw.w = pk2(s[qk][2 * m2 + 1][2], s[qk][2 * m2 + 1][3]); pf[qk][m2] = as_bf8(pw); }
        }
#pragma unroll
        for (int db = 0; db < 4; ++db)
#pragma unroll
            for (int m2 = 0; m2 < 2; ++m2) {
                const bf16_t* vp = Vc + (32 * m2 + 4 * fq + (fr >> 2)) * 72 + 16 * db + 4 * (fr & 3);
                const v4i16_t t0 = __builtin_amdgcn_ds_read_tr16_b64_v4i16((LAS v4i16_t*)vp), t1 = __builtin_amdgcn_ds_read_tr16_b64_v4i16((LAS v4i16_t*)(vp + 16 * 72));
                const bf16x8 vf = __builtin_shufflevector(__builtin_bit_cast(bf16x4_t, t0), __builtin_bit_cast(bf16x4_t, t1), 0, 1, 2, 3, 4, 5, 6, 7);
                O[0][db] = mfma16(vf, pf[0][m2], O[0][db]); O[1][db] = mfma16(vf, pf[1][m2], O[1][db]); }
        if (t + 1 < ntile) store_tile(cur ^ 1, kr[k], vr[k]);
        if (t + 4 < ntile) load_tile(t + 4, kr[k], vr[k]);
        lds_barrier();
            }
        }
    }
    bf16_t* MIX = (bf16_t*)(P.ws + WS_ABUF);
#pragma unroll
    for (int qk = 0; qk < 2; ++qk) { float lt = lsum[qk]; lt += shx(lt, 16, lane); lt += shx(lt, 32, lane); const float inv = __builtin_amdgcn_rcpf(lt);
        bf16_t* orow = MIX + (size_t)(rowbase + q0 + qoff + 16 * qk + fr) * D + 256 + hq * 64;
#pragma unroll
        for (int db = 0; db < 4; ++db) { const f32x4 o = O[qk][db] * inv; u32x2 wv; wv.x = pk2(o[0], o[1]); wv.y = pk2(o[2], o[3]); *(u32x2*)(orow + 16 * db + 4 * fq) = wv; } }
}

__device__ __forceinline__ void convert_gu_dn(const Params& P, int l, unsigned char* lds, int tid_, int gw, int NGW) {
    const int lane = tid_ & 63, wave = tid_ >> 6;
    float* scr = (float*)(lds + wave * 8448);
    constexpr int I_G = 16 * 88, I_D = 44 * 32;
    for (int it = gw; it < 2 * I_G + I_D; it += NGW) {
        int r = it;
        if (r < I_G) { transpose_item<1>(P.in[21] + (size_t)l * 1024 * FF, 1024, FF, 88, (bf16_t*)(P.ws + WS_WGU), scr, r, lane); continue; } r -= I_G;
        if (r < I_G) { transpose_item<2>(P.in[22] + (size_t)l * 1024 * FF, 1024, FF, 88, (bf16_t*)(P.ws + WS_WGU), scr, r, lane); continue; } r -= I_G;
        transpose_item<0>(P.in[23] + (size_t)l * FF * 1024, FF, 1024, 32, (bf16_t*)(P.ws + WS_WDN), scr, r, lane);
    }
}

__device__ __forceinline__ void convert_in_out_l1(const Params& P, unsigned char* lds, int tid_, int gw, int NGW) {
    const int lane = tid_ & 63, wave = tid_ >> 6;
    float* scr = (float*)(lds + wave * 8448);
    constexpr int I_IN = 16 * 88;
    for (int it = gw; it < I_IN; it += NGW) transpose_item<0>(P.in[7] + (size_t)1024 * INW, 1024, INW, 88, (bf16_t*)(P.ws + WS_WIN) + (size_t)INP * 1024, scr, it, lane);
}

__device__ __forceinline__ void phase_e(const Params& P, int l, unsigned char* lds, int tid_, int bid_, int G_) {
    const int tid = tid_, lane = tid & 63, wave = tid >> 6, G = G_;
    const int gw = bid_ * 8 + wave, NGW = G * 8;
    float* scr = (float*)(lds + wave * 8448);
    constexpr int I_O = 16 * 32;
    for (int it = gw; it < I_O; it += NGW) transpose_item<0>(P.in[8] + (size_t)l * 1024 * 1024, 1024, 1024, 32, (bf16_t*)(P.ws + WS_WOUT), scr, it, lane);
    const bf16_t* PROJ = (const bf16_t*)(P.ws + WS_PROJ); const bf16_t* OF = (const bf16_t*)(P.ws + WS_OFB); const bf16_t* OB = OF + (size_t)NTOK * 256;
    bf16_t* MIX = (bf16_t*)(P.ws + WS_ABUF);
    const float* ng = P.in[20] + l * 64;
    const int c4 = lane * 4;
    u32x2 a = (u32x2){0u, 0u}, b = a, z = a;
    if (gw < NTOK) { a = *(const u32x2*)(OF + (size_t)gw * 256 + c4); b = *(const u32x2*)(OB + (size_t)gw * 256 + c4); z = *(const u32x2*)(PROJ + (size_t)gw * INW + 2304 + c4); }
    for (int row = gw; row < NTOK; row += NGW) {
        u32x2 an = a, bn = b, zn = z; const int nr = row + NGW;
        if (nr < NTOK) { an = *(const u32x2*)(OF + (size_t)nr * 256 + c4); bn = *(const u32x2*)(OB + (size_t)nr * 256 + c4); zn = *(const u32x2*)(PROJ + (size_t)nr * INW + 2304 + c4); }
        float o[4] = {bf_lo(a.x) + bf_lo(b.x), bf_hi(a.x) + bf_hi(b.x), bf_lo(a.y) + bf_lo(b.y), bf_hi(a.y) + bf_hi(b.y)};
        float ss = o[0] * o[0] + o[1] * o[1] + o[2] * o[2] + o[3] * o[3];
        ss += shx(ss, 1, lane); ss += shx(ss, 2, lane); ss += shx(ss, 4, lane); ss += shx(ss, 8, lane);
        const float rs = rsqrtf(ss * (1.f / 64.f) + EPS);
        const f32x4 gg = *(const f32x4*)(ng + (c4 & 63));
        const float zz[4] = {bf_lo(z.x), bf_hi(z.x), bf_lo(z.y), bf_hi(z.y)};
        float y[4];
#pragma unroll
        for (int k = 0; k < 4; ++k) y[k] = o[k] * rs * gg[k] * siluf(zz[k]);
        u32x2 wv; wv.x = pk2(y[0], y[1]); wv.y = pk2(y[2], y[3]);
        *(u32x2*)(MIX + (size_t)row * D + 768 + c4) = wv;
        a = an; b = bn; z = zn;
    }
}


#define XB_TMO      128
#define XB_XCNT(j)  (256  + 64 * (j))
#define XB_XSUB(j)  (1280 + 64 * (j))
#define XB_XGEN(j)  (2304 + 64 * (j))
#define XB_TOP      3328
#define XB_TOPGEN   3392
#define XCD_BAR_WORDS 3456
#define XB_SPIN_CAP (1u << 18)
__device__ __forceinline__ unsigned xb_ld(unsigned* p)              { return __hip_atomic_load(p, __ATOMIC_RELAXED, __HIP_MEMORY_SCOPE_AGENT); }
__device__ __forceinline__ unsigned xb_add(unsigned* p, unsigned v) { return __hip_atomic_fetch_add(p, v, __ATOMIC_RELAXED, __HIP_MEMORY_SCOPE_AGENT); }
__device__ __forceinline__ unsigned xb_xcc_id() { return (unsigned)__builtin_amdgcn_s_getreg((3 << 11) | 20) & 0xFu; }
#define XB_SPIN(cond, bar) do { unsigned _sp = 0; while (cond) { __builtin_amdgcn_s_sleep(1); \
    if ((++_sp & 255u) == 0u) { if (xb_ld(&(bar)[XB_TMO])) break; if (_sp > XB_SPIN_CAP) { atomicAdd(&(bar)[XB_TMO], 1u); break; } } } } while (0)
__device__ __forceinline__ void xcd_barrier_complete(unsigned* bar, unsigned x, unsigned G, unsigned& nloc, unsigned& nx) {
    unsigned sum, cnt, mine, sp = 0u;
    for (;;) {
        sum = 0u; cnt = 0u; mine = 0u;
#pragma unroll
        for (unsigned j = 0; j < 16; ++j) { const unsigned c = xb_ld(&bar[XB_XCNT(j)]); sum += c; cnt += (c > 0u) ? 1u : 0u; mine = (j == x) ? c : mine; }
        if (sum == G) break;
        __builtin_amdgcn_s_sleep(1);
        if ((++sp & 255u) == 0u) { if (xb_ld(&bar[XB_TMO])) break; if (sp > XB_SPIN_CAP) { atomicAdd(&bar[XB_TMO], 1u); break; } }
    }
    nloc = mine > 0u ? mine : 1u; nx = cnt > 0u ? cnt : 1u;
}
__device__ __forceinline__ void xcd_barrier(unsigned* bar, volatile LAS unsigned* st, int tid_, unsigned G) {
    asm volatile("s_waitcnt vmcnt(0)" ::: "memory");
    __syncthreads();
    if (tid_ == 0) {
        const unsigned x = xb_xcc_id();
        __builtin_amdgcn_s_waitcnt(0);
        unsigned nloc = st[0], nx = st[1];
        if (nloc == 0u) { xcd_barrier_complete(bar, x, G, nloc, nx); st[0] = nloc; st[1] = nx; }
        const unsigned old = xb_add(&bar[XB_XSUB(x)], 1u);
        const unsigned gen = old / nloc;
        if (old + 1u == (gen + 1u) * nloc) {
            __builtin_amdgcn_fence(__ATOMIC_RELEASE, "agent");
            asm volatile("s_waitcnt vmcnt(0)" ::: "memory");
            const unsigned og = xb_add(&bar[XB_TOP], 1u);
            const unsigned tg = og / nx;
            if (og + 1u == (tg + 1u) * nx) xb_add(&bar[XB_TOPGEN], 1u);
            else XB_SPIN(xb_ld(&bar[XB_TOPGEN]) == tg, bar);
            __builtin_amdgcn_fence(__ATOMIC_ACQUIRE, "agent");
            xb_add(&bar[XB_XGEN(x)], 1u);
            asm volatile("s_waitcnt vmcnt(0)" ::: "memory");
        } else {
            XB_SPIN(xb_ld(&bar[XB_XGEN(x)]) == gen, bar);
            __builtin_amdgcn_fence(__ATOMIC_ACQUIRE, "agent");
            asm volatile("s_waitcnt vmcnt(0)" ::: "memory");
        }
    }
    __syncthreads();
}

__global__ void __launch_bounds__(512, 2) trunk_fwd(Params P0) {
    extern __shared__ __attribute__((aligned(16))) unsigned char lds[];
    cg::grid_group grid = cg::this_grid();
    const int G0 = gridDim.x, b0 = blockIdx.x;
    const int wave0 = __builtin_amdgcn_readfirstlane(threadIdx.x >> 6);
    const int ph_lo = P0.ph_lo, ph_hi = P0.ph_hi;
    {
        unsigned long long* tb = (unsigned long long*)(lds + PTAB_OFF);
        if (threadIdx.x == 0) {
#pragma unroll
            for (int i = 0; i < 24; ++i) tb[i] = (unsigned long long)P0.in[i];
            tb[24] = (unsigned long long)P0.out; tb[25] = (unsigned long long)P0.ws;
            tb[28] = 0ull;
        }
        if (threadIdx.x == 0) (void)xb_add(&((unsigned*)(P0.ws + WS_BAR))[XB_XCNT(xb_xcc_id())], 1u);
        __syncthreads();
    }
    for (int ph = ph_lo; ph < ph_hi; ++ph) {
        int tid, G = G0, b = b0;
        asm volatile("v_mbcnt_lo_u32_b32 %0, -1, 0\n\tv_mbcnt_hi_u32_b32 %0, -1, %0" : "=v"(tid) : : "memory"); tid += wave0 * 64;
        asm volatile("" : "+s"(G), "+s"(b));
        if (ph > ph_lo) {
            unsigned char* wsb; { unsigned tboff = PTAB_OFF; asm volatile("" : "+v"(tboff)); wsb = (unsigned char*)(__attribute__((address_space(1))) unsigned char*)uni64(((const unsigned long long*)(lds + tboff))[25]); }
            xcd_barrier((unsigned*)(wsb + WS_BAR), (volatile LAS unsigned*)(lds + PTAB_OFF + 224), tid, (unsigned)G);
            if (ph_hi > 1000) grid.sync();
        }
        Params P;
        {   unsigned tboff = PTAB_OFF; asm volatile("" : "+v"(tboff));
            const unsigned long long* tb = (const unsigned long long*)(lds + tboff);
#pragma unroll
            for (int i = 0; i < 24; ++i) P.in[i] = (const float*)(const __attribute__((address_space(1))) float*)uni64(tb[i]);
            P.out = (float*)(__attribute__((address_space(1))) float*)uni64(tb[24]); P.ws = (unsigned char*)(__attribute__((address_space(1))) unsigned char*)uni64(tb[25]); P.ph_lo = 0; P.ph_hi = 0; }
        float* X = P.out;
        const float* modw = (const float*)(P.ws + WS_MOD);
        bf16_t* ABUF = (bf16_t*)(P.ws + WS_ABUF);
        if (ph == 0) { phase0(P, lds, tid, b, G); continue; }
        const int l = (ph - 1) / 9, sub = (ph - 1) % 9;
        const float* modl = modw + (size_t)l * 5 * 6144;
        const float* xa = l == 0 ? P.in[0] : X; const float* xb = l == 0 ? P.in[1] : X + (size_t)NPT * D;
        if (sub == 1 || sub == 5 || sub == 7 || sub == 8) {
            pg8::Gemm g; EpiAny E;
            const bool s1 = sub == 1, s5 = sub == 5, s7 = sub == 7, s8 = sub == 8;
            unsigned long long a_off = s8 ? WS_PROJ : WS_ABUF;
            unsigned long long b_off = s1 ? WS_WIN + (unsigned long long)l * INP * 1024 * 2 : (s5 ? WS_WOUT : (s7 ? WS_WGU : WS_WDN));
            int nn = s1 ? INP : (s7 ? FF2 : D), kk = s8 ? FF : D, mode = s1 ? 0 : (s7 ? 2 : 1), goff = s8 ? 5120 : 2048;
            const float* exa = s5 ? xa : X; const float* exb = s5 ? xb : X + (size_t)NPT * D;
            asm volatile("" : "+s"(a_off), "+s"(b_off), "+s"(nn), "+s"(kk), "+s"(mode), "+s"(goff), "+s"(exa), "+s"(exb));
            g.M = NTOK; g.A = (const bf16_t*)(P.ws + a_off); g.Bt = (const bf16_t*)(P.ws + b_off); g.N = nn; g.K = kk;
            E.O = (bf16_t*)(P.ws + WS_PROJ); E.xa = exa; E.xb = exb; E.modl = modl; E.out = X; E.goff = goff; E.mode = mode; E.perm = mode != 1;
            pg8::StaticOrder S; S.init(NTOK, g.N, G, b);
            pg8::gemm_phase<EpiAny, pg8::StaticOrder, true, true>((LAS unsigned char*)lds, g, S, E, tid);
            if (s5) {
                const int two = 320 - G;
                const int first = (two > 0 && two < G) ? two : 0, nh = G - first;
                if (b >= first) { __syncthreads(); convert_gu_dn(P, l, lds, tid, (b - first) * 8 + (tid >> 6), nh * 8); }
            }
            if (s8 && l == 0) {
                const int two = 320 - G; const int first = (two > 0 && two < G) ? two : 0, nh = G - first;
                if (b >= first) { __syncthreads(); convert_in_out_l1(P, lds, tid, (b - first) * 8 + (tid >> 6), nh * 8); }
            }
            continue;
        }
        switch (sub) {
        case 0: norm_phase(xa, xb, P.in[11] + l * D, modl, 0, 1024, ABUF, tid, b, G);
            break;
        case 2: { prep_rows(P, l, lds, tid, b, G); for (int it = b; it < 1280; it += G) dn_chunk_item(P, l, it, lds, tid);
        } break;
        case 3: {
            const int nA = G > 128 ? 64 : 0;
            if (b < nA) { dn_scan_chain<1>(P, l, 128 + (b >> 1), b & 1, lds, tid); }
            else { const int bb = b - nA, GB = G - nA;
                if (nA == 0) for (int ch = bb; ch < 32; ch += GB) dn_scan_chain<2>(P, l, 128 + ch, 0, lds, tid);
                for (int ch = bb; ch < 128; ch += GB) dn_scan_chain<2>(P, l, ch, 0, lds, tid);
            }
            {
                unsigned* ctr = (unsigned*)(P.ws + WS_BAR) + 3584 + 64 * l;
                volatile LAS unsigned* wsl = (volatile LAS unsigned*)(lds + PTAB_OFF + 232);
                for (;;) {
                    __syncthreads();
                    if (tid == 0) wsl[0] = xb_add(ctr, 1u);
                    __syncthreads();
                    const unsigned u = wsl[0];
                    if (u >= 640u) break;
                    attn_unit(P, l, (int)u, lds, tid);
                }
            }
        } break;
        case 4: phase_e(P, l, lds, tid, b, G);
            break;
        case 6: norm_phase(X, X + (size_t)NPT * D, P.in[12] + l * D, modl, 3072, 4096, ABUF, tid, b, G); break;
        default: break;
        }
    }
}

extern "C" void kernel_launch(void* const* d_in, const int* in_sizes, int n_in, void* d_out, int out_size, void* d_ws, size_t ws_size, hipStream_t stream) {
    static int grid = 0;
    if (grid == 0) {
        if (n_in != 24 || ws_size < WS_END) { fprintf(stderr, "kernel_launch: unexpected n_in %d / ws %zu (need %zu)\n", n_in, ws_size, (size_t)WS_END); grid = -1; return; }
        int dev = 0, cus = 0, per_cu = 0;
        hipGetDevice(&dev); hipDeviceGetAttribute(&cus, hipDeviceAttributeMultiprocessorCount, dev);
        if (hipFuncSetAttribute((const void*)trunk_fwd, hipFuncAttributeMaxDynamicSharedMemorySize, LDS_BYTES) != hipSuccess) { fprintf(stderr, "hipFuncSetAttribute failed\n"); grid = -1; return; }
        if (hipOccupancyMaxActiveBlocksPerMultiprocessor(&per_cu, (const void*)trunk_fwd, 512, LDS_BYTES) != hipSuccess || per_cu < 1) { fprintf(stderr, "occupancy query failed (%d)\n", per_cu); per_cu = 1; }
        (void)hipGetLastError();
        grid = cus * (per_cu > 1 ? 1 : per_cu);
    }
    if (grid < 0) return;
    Params p{};
    for (int i = 0; i < 24; ++i) p.in[i] = (const float*)d_in[i];
    p.out = (float*)d_out; p.ws = (unsigned char*)d_ws; p.ph_lo = 0; p.ph_hi = 19;
    if (hipMemsetAsync((unsigned char*)d_ws + WS_BAR, 0, 16384, stream) != hipSuccess) { fprintf(stderr, "hipMemsetAsync of the barrier words failed\n"); return; }
    void* args[] = {&p};
    hipError_t e = hipLaunchCooperativeKernel((const void*)trunk_fwd, dim3(grid), dim3(512), args, LDS_BYTES, stream);
    if (e != hipSuccess) fprintf(stderr, "cooperative launch failed: %s (grid %d)\n", hipGetErrorString(e), grid);
}
```

```cpp
#include <hip/hip_runtime.h>

#include <hip/hip_cooperative_groups.h>
#include <cstdio>
#include <cstdint>
namespace cg = cooperative_groups;

#define LAS __attribute__((address_space(3)))
typedef unsigned short bf16_t;
typedef short bf16x8 __attribute__((ext_vector_type(8)));
typedef float f32x4 __attribute__((ext_vector_type(4)));
typedef unsigned u32x4 __attribute__((ext_vector_type(4)));
typedef unsigned u32x2 __attribute__((ext_vector_type(2)));
typedef short v4i16_t __attribute__((ext_vector_type(4)));
typedef short bf16x4_t __attribute__((ext_vector_type(4)));

constexpr int D = 1024, NTOK = 20480, NPT = 4096, INW = 2576, INP = 2816, FF = 2816, FF2 = 5632;
constexpr float EPS = 1e-6f;
constexpr float LOG2E = 1.4426950408889634f;
constexpr size_t OUT_K = 20971520, OUT_V = 22020096, OUT_S = 23068672;
constexpr size_t WS_WIN = 0;
constexpr size_t WS_ABUF = 11534336;
constexpr size_t WS_PROJ = WS_ABUF + 41943040;
constexpr size_t WS_DN = WS_PROJ + 115343360;
constexpr size_t DN_MAT = 2560ull * 8192ull;
constexpr size_t WS_WOUT = WS_DN, WS_WGU = WS_DN + 2097152, WS_WDN = WS_WGU + 11534336;
constexpr size_t WS_OFB = WS_DN + 3 * DN_MAT;
constexpr size_t WS_MOD = WS_OFB + 20971520;
constexpr size_t WS_DNG = WS_MOD + 245760;
constexpr size_t WS_BAR = WS_DNG + 10240;
constexpr size_t WS_CK = WS_BAR + 16384;
constexpr size_t WS_CV = WS_CK + 524288;
constexpr size_t WS_END = WS_CV + 524288;
constexpr int LDS_BYTES = 147456;
constexpr int PTAB_OFF = LDS_BYTES - 256;

struct Params {
    const float* in[24];
    float* out; unsigned char* ws;
    int ph_lo, ph_hi;
};

__device__ __forceinline__ unsigned f2bf(float f) { unsigned u = __float_as_uint(f); return (u + 0x7fffu + ((u >> 16) & 1u)) >> 16; }
__device__ __forceinline__ unsigned pk2(float lo, float hi) { typedef float f32x2_t __attribute__((ext_vector_type(2))); typedef __bf16 bf16x2_t __attribute__((ext_vector_type(2))); f32x2_t v = {lo, hi}; return __builtin_bit_cast(unsigned, __builtin_convertvector(v, bf16x2_t)); }
__device__ __forceinline__ float bf_lo(unsigned u) { return __uint_as_float(u << 16); }
__device__ __forceinline__ float bf_hi(unsigned u) { return __uint_as_float(u & 0xffff0000u); }
__device__ __forceinline__ float bf2f(bf16_t b) { return __uint_as_float(((unsigned)b) << 16); }
__device__ __forceinline__ void unpack8(u32x4 r, float* x) {
    x[0] = bf_lo(r.x); x[1] = bf_hi(r.x); x[2] = bf_lo(r.y); x[3] = bf_hi(r.y); x[4] = bf_lo(r.z); x[5] = bf_hi(r.z); x[6] = bf_lo(r.w); x[7] = bf_hi(r.w);
}
__device__ __forceinline__ u32x4 pack8(const float* x) { u32x4 r; r.x = pk2(x[0], x[1]); r.y = pk2(x[2], x[3]); r.z = pk2(x[4], x[5]); r.w = pk2(x[6], x[7]); return r; }
__device__ __forceinline__ float siluf(float x) { return x * __builtin_amdgcn_rcpf(1.f + __expf(-x)); }
__device__ __forceinline__ int mi_of(int row) { return row < NPT ? 0 : 1 + ((row - NPT) >> 12); }
__device__ __forceinline__ f32x4 mfma16(bf16x8 a, bf16x8 b, f32x4 c) { return __builtin_amdgcn_mfma_f32_16x16x32_bf16(a, b, c, 0, 0, 0); }
__device__ __forceinline__ bf16x8 as_bf8(u32x4 v) { return __builtin_bit_cast(bf16x8, v); }

__device__ __forceinline__ float shx(float v, int m, int lane) { return __int_as_float(__builtin_amdgcn_ds_bpermute((lane ^ m) << 2, __float_as_int(v))); }
__device__ __forceinline__ float shl_(float v, int src, int  ) { return __int_as_float(__builtin_amdgcn_ds_bpermute(src << 2, __float_as_int(v))); }
__device__ __forceinline__ void lds_barrier() { asm volatile("s_waitcnt lgkmcnt(0)" ::: "memory"); __builtin_amdgcn_s_barrier(); asm volatile("" ::: "memory"); }
__device__ __forceinline__ unsigned long long uni64(unsigned long long v) { const unsigned lo = __builtin_amdgcn_readfirstlane((unsigned)v), hi = __builtin_amdgcn_readfirstlane((unsigned)(v >> 32)); return ((unsigned long long)hi << 32) | lo; }
namespace pg8 {
constexpr int BM = 256, BK = 64, HALF = 128, HTB = HALF * BK * 2, STAGE_BYTES = 8 * HTB, NXCD = 8, WGM = 8;
__host__ __device__ __forceinline__ int lds_byte(int r, int c) { const int st = (r >> 4) * 2 + (c >> 5), rr = r & 15, cc = c & 31, ob = rr * 64 + cc * 2; return st * 1024 + (ob ^ (((ob >> 9) & 1) << 5)); }
__host__ __device__ __forceinline__ void stage_rc(int b, int& R, int& C) { const int st = b / 1024, sb = b % 1024, swz = sb ^ (((sb >> 9) & 1) << 5); R = (st >> 1) * 16 + swz / 64; C = (st & 1) * 32 + (swz % 64) / 2; }
__host__ __device__ __forceinline__ int perm32(int rho) { const int n = rho >> 4, i = rho & 15; return 8 * (i >> 2) + 4 * n + (i & 3); }
struct Unit { int pm, pn; };
struct Gemm { const bf16_t* A; const bf16_t* Bt; int M, N, K; };
struct StaticOrder {
    int nM, nN, nwg, G, c;
    __device__ void init(int M, int N, int G_, int c_) { nM = M / BM; nN = N / BM; nwg = nM * nN; G = G_; c = c_; }
    __device__ bool next(int i, Unit& u) const {
        const long L = (long)i * G + c; if (L >= nwg) return false;
        int wgid = (int)L; { const int q = nwg / NXCD, r = nwg % NXCD, xcd = wgid % NXCD, off = wgid / NXCD; wgid = (xcd < r ? xcd * (q + 1) : r * (q + 1) + (xcd - r) * q) + off; }
        const int nig = WGM * nN, gid = wgid / nig, fm = gid * WGM, gsz = (nM - fm) < WGM ? (nM - fm) : WGM;
        u.pm = fm + ((wgid % nig) % gsz); u.pn = (wgid % nig) / gsz; return true;
    }
};
__device__ __forceinline__ unsigned cvt_pk_bf16(float lo, float hi) { unsigned r; asm volatile("v_cvt_pk_bf16_f32 %0, %1, %2" : "=v"(r) : "v"(lo), "v"(hi)); return r; }

template <class Epi, class Sched, bool ALIGN_EPI = false, bool SP2 = false>
__device__ __forceinline__ void gemm_phase(LAS unsigned char* lds, const Gemm g, const Sched& S, const Epi& E, int tid_) {
    const int tid = tid_, wid = __builtin_amdgcn_readfirstlane(tid >> 6), lane = tid & 63, wr = wid >> 2, wc = wid & 3, fr = lane & 15, fq = lane >> 4;
    const int K = g.K, nt = K / BK;
    unsigned voffA[2], voffB[2];
#pragma unroll
    for (int i = 0; i < 2; ++i) { int R, C; stage_rc(tid * 16 + i * 8192, R, C); const int Rb = E.perm ? ((R & ~31) + perm32(R & 31)) : R;
        voffA[i] = (unsigned)(R * K + C) * 2u; voffB[i] = (unsigned)(Rb * K + C) * 2u; }
    const size_t kstep = (size_t)(BK * 2);
    const size_t hstep = (size_t)HALF * K * 2;
    const size_t tstep = 2 * hstep;
    const unsigned ldsw = (unsigned)wid * 1024u;
    const int aoff = lds_byte(wr * 64 + fr, fq * 8), boff = lds_byte(wc * 32 + fr, fq * 8);
#define PG8_SA(b, h) (((b) * 2 + (h)) * HTB)
#define PG8_SB(b, h) ((4 + (b) * 2 + (h)) * HTB)
#define PG8_STAGE(bufoff, gbase, voff) do { _Pragma("unroll") for (int _i = 0; _i < 2; ++_i) \
        __builtin_amdgcn_global_load_lds((const unsigned*)((const char*)(gbase) + (voff)[_i]), (LAS unsigned*)(lds + (bufoff) + ldsw + _i * 8192), 16, 0, 0); } while (0)
#define PG8_LDA(dst, b, h) do { _Pragma("unroll") for (int m = 0; m < 4; ++m) _Pragma("unroll") for (int k = 0; k < 2; ++k) dst[m][k] = *(const LAS bf16x8*)(lds + PG8_SA(b, h) + aoff + m * 2048 + k * 1024); } while (0)
#define PG8_LDB(dst, b, h) do { _Pragma("unroll") for (int n = 0; n < 2; ++n) _Pragma("unroll") for (int k = 0; k < 2; ++k) dst[n][k] = *(const LAS bf16x8*)(lds + PG8_SB(b, h) + boff + n * 2048 + k * 1024); } while (0)
#define PG8_MMA(ai, bj, At, Bt) do { __builtin_amdgcn_s_setprio(1); _Pragma("unroll") for (int m = 0; m < 4; ++m) _Pragma("unroll") for (int n = 0; n < 2; ++n) _Pragma("unroll") for (int k = 0; k < 2; ++k) \
        acc[ai][bj][m][n] = __builtin_amdgcn_mfma_f32_16x16x32_bf16(Bt[n][k], At[m][k], acc[ai][bj][m][n], 0, 0, 0); __builtin_amdgcn_s_setprio(0); } while (0)
#define PG8_WAIT_V(n) asm volatile("s_waitcnt vmcnt(" #n ")" ::: "memory")
#define PG8_WAIT_L(n) asm volatile("s_waitcnt lgkmcnt(" #n ")" ::: "memory")
#define PG8_BAR __builtin_amdgcn_s_barrier()
#define PG8_SCHED __builtin_amdgcn_sched_barrier(0)
    Unit cur, nxt; int ui = 0;
    if (!S.next(0, cur)) return;
    f32x4 acc[2][2][4][2];
#pragma unroll
    for (int a = 0; a < 2; ++a)
#pragma unroll
        for (int b = 0; b < 2; ++b)
#pragma unroll
            for (int m = 0; m < 4; ++m)
#pragma unroll
                for (int n = 0; n < 2; ++n) acc[a][b][m][n] = (f32x4){0.f, 0.f, 0.f, 0.f};
    bf16x8 At[4][2], B0[2][2], B1[2][2];
    const char* cA = (const char*)g.A + (size_t)cur.pm * tstep; const char* cB = (const char*)g.Bt + (size_t)cur.pn * tstep;
    if constexpr (SP2) {
        PG8_STAGE(PG8_SB(0, 0), cB, voffB); PG8_STAGE(PG8_SB(0, 1), cB + hstep, voffB); PG8_STAGE(PG8_SA(0, 0), cA, voffA); PG8_STAGE(PG8_SA(0, 1), cA + hstep, voffA);
        if (wr == 1) PG8_BAR;
        PG8_WAIT_V(2); PG8_BAR;
        PG8_STAGE(PG8_SB(1, 0), cB + kstep, voffB); PG8_STAGE(PG8_SA(1, 0), cA + kstep, voffA); PG8_STAGE(PG8_SB(1, 1), cB + hstep + kstep, voffB);
        PG8_WAIT_V(6); PG8_BAR;
    } else {
        PG8_STAGE(PG8_SB(0, 0), cB, voffB); PG8_STAGE(PG8_SA(0, 0), cA, voffA); PG8_STAGE(PG8_SB(0, 1), cB + hstep, voffB); PG8_STAGE(PG8_SA(0, 1), cA + hstep, voffA);
        if (wr == 1) PG8_BAR;
        PG8_WAIT_V(4); PG8_BAR;
        PG8_STAGE(PG8_SB(1, 0), cB + kstep, voffB); PG8_STAGE(PG8_SA(1, 0), cA + kstep, voffA); PG8_STAGE(PG8_SB(1, 1), cB + hstep + kstep, voffB);
        PG8_WAIT_V(6); PG8_BAR;
    }
    for (;;) {
        const bool has_next = S.next(ui + 1, nxt);
        const char* nA = has_next ? (const char*)g.A + (size_t)nxt.pm * tstep : cA; const char* nB = has_next ? (const char*)g.Bt + (size_t)nxt.pn * tstep : cB;
        for (int t = 0; t < nt; t += 2) {
            const bool last = (t == nt - 2);
            const char* a1 = cA + (size_t)(t + 1) * kstep;
            const char* a2 = last ? nA : cA + (size_t)(t + 2) * kstep; const char* b2 = last ? nB : cB + (size_t)(t + 2) * kstep;
            const char* a3 = a2 + kstep; const char* b3 = b2 + kstep;
            if constexpr (SP2) {
            PG8_LDB(B0, 0, 0); PG8_LDB(B1, 0, 1); PG8_SCHED; PG8_LDA(At, 0, 0); PG8_STAGE(PG8_SA(1, 1), a1 + hstep, voffA);
            PG8_WAIT_V(8); PG8_WAIT_L(0); PG8_BAR; PG8_MMA(0, 0, At, B0); PG8_MMA(0, 1, At, B1); PG8_BAR; PG8_SCHED;
            PG8_LDA(At, 0, 1); PG8_STAGE(PG8_SB(0, 0), b2, voffB); PG8_STAGE(PG8_SB(0, 1), b2 + hstep, voffB); PG8_STAGE(PG8_SA(0, 0), a2, voffA);
            PG8_WAIT_V(8); PG8_WAIT_L(0); PG8_BAR; PG8_MMA(1, 0, At, B0); PG8_MMA(1, 1, At, B1); PG8_BAR; PG8_SCHED;
            PG8_LDB(B0, 1, 0); PG8_LDB(B1, 1, 1); PG8_SCHED; PG8_LDA(At, 1, 0); PG8_STAGE(PG8_SA(0, 1), a2 + hstep, voffA);
            PG8_WAIT_V(8); PG8_WAIT_L(0); PG8_BAR; PG8_MMA(0, 0, At, B0); PG8_MMA(0, 1, At, B1); PG8_BAR; PG8_SCHED;
            PG8_LDA(At, 1, 1); PG8_STAGE(PG8_SB(1, 0), b3, voffB); PG8_STAGE(PG8_SB(1, 1), b3 + hstep, voffB); PG8_STAGE(PG8_SA(1, 0), a3, voffA);
            PG8_WAIT_V(8); PG8_WAIT_L(0); PG8_BAR; PG8_MMA(1, 0, At, B0); PG8_MMA(1, 1, At, B1); PG8_BAR; PG8_SCHED;
            } else {
            PG8_LDB(B0, 0, 0); PG8_SCHED; PG8_LDA(At, 0, 0); PG8_STAGE(PG8_SA(1, 1), a1 + hstep, voffA);
            PG8_WAIT_L(8); PG8_BAR; PG8_WAIT_L(0); PG8_MMA(0, 0, At, B0); PG8_BAR; PG8_SCHED;
            PG8_LDB(B1, 0, 1); PG8_STAGE(PG8_SB(0, 0), b2, voffB);
            PG8_BAR; PG8_WAIT_L(0); PG8_MMA(0, 1, At, B1); PG8_BAR;
            PG8_LDA(At, 0, 1); PG8_STAGE(PG8_SA(0, 0), a2, voffA);
            PG8_BAR; PG8_WAIT_L(0); PG8_MMA(1, 0, At, B0); PG8_BAR; PG8_SCHED;
            PG8_STAGE(PG8_SB(0, 1), b2 + hstep, voffB);
            PG8_WAIT_V(6); PG8_BAR; PG8_MMA(1, 1, At, B1); PG8_BAR;
            PG8_LDB(B0, 1, 0); PG8_SCHED; PG8_LDA(At, 1, 0); PG8_STAGE(PG8_SA(0, 1), a2 + hstep, voffA);
            PG8_WAIT_L(8); PG8_BAR; PG8_WAIT_L(0); PG8_MMA(0, 0, At, B0); PG8_BAR; PG8_SCHED;
            PG8_LDB(B1, 1, 1); PG8_STAGE(PG8_SB(1, 0), b3, voffB);
            PG8_BAR; PG8_WAIT_L(0); PG8_MMA(0, 1, At, B1); PG8_BAR;
            PG8_LDA(At, 1, 1); PG8_STAGE(PG8_SA(1, 0), a3, voffA);
            PG8_BAR; PG8_WAIT_L(0); PG8_MMA(1, 0, At, B0); PG8_BAR; PG8_SCHED;
            PG8_STAGE(PG8_SB(1, 1), b3 + hstep, voffB);
            PG8_WAIT_V(6); PG8_BAR; PG8_MMA(1, 1, At, B1); PG8_BAR;
            }
        }
        if constexpr (ALIGN_EPI) { if (wr == 0) PG8_BAR; }
        E(acc, cur, wr, wc, fr, fq);
        if (!has_next) break;
#pragma unroll
        for (int a = 0; a < 2; ++a)
#pragma unroll
            for (int b = 0; b < 2; ++b)
#pragma unroll
                for (int m = 0; m < 4; ++m)
#pragma unroll
                    for (int n = 0; n < 2; ++n) acc[a][b][m][n] = (f32x4){0.f, 0.f, 0.f, 0.f};
        cur = nxt; cA = nA; cB = nB; ++ui;
        if constexpr (ALIGN_EPI) { if (wr == 1) PG8_BAR; }
    }
    PG8_WAIT_V(0);
    if constexpr (!ALIGN_EPI) { if (wr == 0) PG8_BAR; }
    PG8_BAR;
#undef PG8_SA
#undef PG8_SB
#undef PG8_STAGE
#undef PG8_LDA
#undef PG8_LDB
#undef PG8_MMA
#undef PG8_WAIT_V
#undef PG8_WAIT_L
#undef PG8_BAR
#undef PG8_SCHED
}
}

struct EpiAny {
    int mode; bool perm;
    bf16_t* O; const float* xa; const float* xb; const float* modl; int goff; float* out;
    __device__ __forceinline__ void operator()(const f32x4 (&acc)[2][2][4][2], const pg8::Unit& u, int wr, int wc, int fr, int fq) const {
        const int row0 = u.pm * 256 + wr * 64 + fr;
        if (mode == 0) {
            const int col0 = u.pn * 256 + wc * 32 + 8 * fq;
#pragma unroll
            for (int ai = 0; ai < 2; ++ai)
#pragma unroll
                for (int m = 0; m < 4; ++m) { bf16_t* rowp = O + (size_t)(row0 + ai * 128 + m * 16) * INW;
#pragma unroll
                    for (int bj = 0; bj < 2; ++bj) { const int col = col0 + bj * 128;
                        if (col < INW) { const f32x4 v0 = acc[ai][bj][m][0], v1 = acc[ai][bj][m][1]; u32x4 w;
                            w.x = pg8::cvt_pk_bf16(v0[0], v0[1]); w.y = pg8::cvt_pk_bf16(v0[2], v0[3]); w.z = pg8::cvt_pk_bf16(v1[0], v1[1]); w.w = pg8::cvt_pk_bf16(v1[2], v1[3]);
                            *(u32x4*)(rowp + col) = w; } } }
        } else if (mode == 1) {
            const int col0 = u.pn * 256 + wc * 32 + 4 * fq;
            const float* gp = modl + mi_of(u.pm * 256) * 6144 + goff;
#pragma unroll
            for (int ai = 0; ai < 2; ++ai)
#pragma unroll
                for (int m = 0; m < 4; ++m) { const int row = row0 + ai * 128 + m * 16;
                    const float* xs = row < NPT ? xa + (size_t)row * D : xb + (size_t)(row - NPT) * D; float* o = out + (size_t)row * D;
#pragma unroll
                    for (int bj = 0; bj < 2; ++bj)
#pragma unroll
                        for (int n = 0; n < 2; ++n) { const int col = col0 + bj * 128 + n * 16;
                            const f32x4 xv = *(const f32x4*)(xs + col), gv = *(const f32x4*)(gp + col);
                            *(f32x4*)(o + col) = xv + gv * acc[ai][bj][m][n]; } }
        } else {
#pragma unroll
            for (int ai = 0; ai < 2; ++ai)
#pragma unroll
                for (int m = 0; m < 4; ++m) { bf16_t* rowp = O + (size_t)(row0 + ai * 128 + m * 16) * FF;
                    const int oc = u.pn * 128 + wc * 32 + 8 * fq;
                    float a[8];
#pragma unroll
                    for (int n = 0; n < 2; ++n) { const f32x4 gt = acc[ai][0][m][n], up = acc[ai][1][m][n];
#pragma unroll
                        for (int k = 0; k < 4; ++k) a[4 * n + k] = gt[k] * __builtin_amdgcn_rcpf(1.f + __expf(-gt[k])) * up[k]; }
                    u32x4 w; w.x = pg8::cvt_pk_bf16(a[0], a[1]); w.y = pg8::cvt_pk_bf16(a[2], a[3]); w.z = pg8::cvt_pk_bf16(a[4], a[5]); w.w = pg8::cvt_pk_bf16(a[6], a[7]);
                    *(u32x4*)(rowp + oc) = w; }
        }
    }
};

template <int MODE>
__device__ __forceinline__ void transpose_item(const float* W, int K, int N, int nblk, bf16_t* WT, float* scr, int item, int lane) {
    const int kb = item / nblk, nb = item % nblk, k0 = 64 * kb, n0 = 32 * nb;
    const int nn = n0 + (lane & 31);
#pragma unroll
    for (int i = 0; i < 32; ++i) { const int kk = 2 * i + (lane >> 5); scr[kk * 33 + (lane & 31)] = (nn < N) ? W[(size_t)(k0 + kk) * N + nn] : 0.f; }
    __builtin_amdgcn_fence(__ATOMIC_RELEASE, "wavefront"); asm volatile("s_waitcnt lgkmcnt(0)" ::: "memory");
    const int c = lane & 7;
#pragma unroll
    for (int j = 0; j < 4; ++j) { const int n = (lane >> 3) + 8 * j; const float* s = scr + (8 * c) * 33 + n;
        u32x4 o; o.x = pk2(s[0 * 33], s[1 * 33]); o.y = pk2(s[2 * 33], s[3 * 33]); o.z = pk2(s[4 * 33], s[5 * 33]); o.w = pk2(s[6 * 33], s[7 * 33]);
        int row;
        if (MODE == 0) row = n0 + n; else row = 256 * (n0 >> 7) + (n0 & 127) + n + (MODE == 2 ? 128 : 0);
        *(u32x4*)(WT + (size_t)row * K + k0 + 8 * c) = o; }
    asm volatile("s_waitcnt lgkmcnt(0)" ::: "memory");
}

__device__ __forceinline__ void phase0(const Params& P, unsigned char* lds, int tid_, int bid_, int G_) {
    const int tid = tid_, lane = tid & 63, wave = tid >> 6, G = G_;
    float* sc = (float*)lds;
    float* red = (float*)(lds + 20480);
    float* modw = (float*)(P.ws + WS_MOD);
    if ((int)bid_ < 192) {
        for (int i = tid; i < 5 * 1024; i += 512) { const int mi = i >> 10, k = i & 1023; const float c = mi == 0 ? P.in[6][k] : P.in[5][(mi - 1) * 1024 + k]; sc[i] = c / (1.f + expf(-c)); }
        __syncthreads();
        for (int item = bid_; item < 192; item += G) {
            const int l = item / 96, cgp = item % 96, col = cgp * 64 + (tid & 15) * 4, kr = tid >> 4;
            const float* aw = P.in[9] + (size_t)l * 1024 * 6144;
            float acc[5][4];
#pragma unroll
            for (int mi = 0; mi < 5; ++mi)
#pragma unroll
                for (int j = 0; j < 4; ++j) acc[mi][j] = 0.f;
#pragma unroll 4
            for (int kk = kr; kk < 1024; kk += 32) { const f32x4 w = *(const f32x4*)(aw + (size_t)kk * 6144 + col);
#pragma unroll
                for (int mi = 0; mi < 5; ++mi) { const float s = sc[mi * 1024 + kk]; acc[mi][0] += s * w[0]; acc[mi][1] += s * w[1]; acc[mi][2] += s * w[2]; acc[mi][3] += s * w[3]; } }
#pragma unroll
            for (int mi = 0; mi < 5; ++mi)
#pragma unroll
                for (int j = 0; j < 4; ++j) red[(kr * 5 + mi) * 64 + (tid & 15) * 4 + j] = acc[mi][j];
            __syncthreads();
            if (tid < 320) { const int mi = tid >> 6, c = tid & 63; float s = 0.f;
                for (int r = 0; r < 32; ++r) s += red[(r * 5 + mi) * 64 + c];
                modw[((size_t)l * 5 + mi) * 6144 + cgp * 64 + c] = s + P.in[10][(size_t)l * 6144 + cgp * 64 + c]; }
            __syncthreads();
        }
    }
    __syncthreads();
    float* scr = (float*)(lds + 65536 + wave * 8448);
    const int gw = bid_ * 8 + wave, NGW = G * 8;
    constexpr int I_IN = 16 * 88;
    for (int it = gw; it < I_IN; it += NGW) { const int l = 0, r = it;
        transpose_item<0>(P.in[7] + (size_t)l * 1024 * INW, 1024, INW, 88, (bf16_t*)(P.ws + WS_WIN) + (size_t)l * INP * 1024, scr, r, lane); }
}

__device__ __forceinline__ void norm_phase(const float* xa, const float* xb, const float* g, const float* modl, int sh_off, int sc_off, bf16_t* H, int tid_, int bid_, int G_) {
    const int lane = tid_ & 63, wave = tid_ >> 6;
    const int gw = bid_ * 8 + wave, NGW = G_ * 8;
    auto ld = [&](int row, f32x4 (&v)[4]) { const float* x = row < NPT ? xa + (size_t)row * D : xb + (size_t)(row - NPT) * D;
#pragma unroll
        for (int j = 0; j < 4; ++j) v[j] = *(const f32x4*)(x + 4 * lane + 256 * j); };
    f32x4 v[4], v1[4], v2[4];
#pragma unroll
    for (int j = 0; j < 4; ++j) { v[j] = (f32x4){0.f, 0.f, 0.f, 0.f}; v1[j] = v[j]; v2[j] = v[j]; }
    if (gw < NTOK) ld(gw, v);
    if (gw + NGW < NTOK) ld(gw + NGW, v1);
    for (int row = gw; row < NTOK; row += NGW) {
        if (row + 2 * NGW < NTOK) ld(row + 2 * NGW, v2);
        const float* md = modl + mi_of(row) * 6144;
        float ss = 0.f;
#pragma unroll
        for (int j = 0; j < 4; ++j) ss += (v[j][0] * v[j][0] + v[j][1] * v[j][1]) + (v[j][2] * v[j][2] + v[j][3] * v[j][3]);
#pragma unroll
        for (int o = 1; o < 64; o <<= 1) ss += shx(ss, o, lane);
        const float rstd = rsqrtf(ss * (1.f / D) + EPS);
#pragma unroll
        for (int j = 0; j < 4; ++j) { const int col = 4 * lane + 256 * j;
            const f32x4 gg = *(const f32x4*)(g + col), scv = *(const f32x4*)(md + sc_off + col), shv = *(const f32x4*)(md + sh_off + col);
            f32x4 h = v[j] * rstd * gg * (scv + 1.f) + shv;
            u32x2 w; w.x = pk2(h[0], h[1]); w.y = pk2(h[2], h[3]);
            *(u32x2*)(H + (size_t)row * D + col) = w; }
#pragma unroll
        for (int j = 0; j < 4; ++j) { v[j] = v1[j]; v1[j] = v2[j]; }
    }
}

__device__ __forceinline__ void prep_rows(const Params& P, int l, unsigned char* lds, int tid_, int bid_, int G_) {
    const int tid = tid_, lane = tid & 63, wave = tid >> 6;
    float* tab = (float*)lds;
    for (int i = tid; i < 1024; i += 512) { const int pos = i >> 4, k = i & 15; const float inv = exp2f(-(float)k * (13.287712379549449f / 16.f)); float s, c; sincosf((float)pos * inv, &s, &c); tab[2 * i] = c; tab[2 * i + 1] = s; }
    __syncthreads();
    {
        bf16_t* ck = (bf16_t*)(P.ws + WS_CK); bf16_t* cv = (bf16_t*)(P.ws + WS_CV);
        for (int i = (bid_ * 512 + tid) * 8; i < 4 * 512 * 128; i += G_ * 512 * 8) { const int sq_ = i >> 16, rem = i & 65535;
            const size_t src_i = ((size_t)(sq_ * 2 + l) << 16) + rem;
            const f32x4 a = *(const f32x4*)(P.in[2] + src_i), b2 = *(const f32x4*)(P.in[2] + src_i + 4), c = *(const f32x4*)(P.in[3] + src_i), d = *(const f32x4*)(P.in[3] + src_i + 4);
            u32x4 w; w.x = pk2(a[0], a[1]); w.y = pk2(a[2], a[3]); w.z = pk2(b2[0], b2[1]); w.w = pk2(b2[2], b2[3]); *(u32x4*)(ck + i) = w;
            w.x = pk2(c[0], c[1]); w.y = pk2(c[2], c[3]); w.z = pk2(d[0], d[1]); w.w = pk2(d[2], d[3]); *(u32x4*)(cv + i) = w; }
    }
    bf16_t* PROJ = (bf16_t*)(P.ws + WS_PROJ); bf16_t* MIX = (bf16_t*)(P.ws + WS_ABUF);
    const float* qg = P.in[15] + l * 64; const float* kg = P.in[16] + l * 64; const float* cw = P.in[13] + (size_t)l * 3 * 256;
    const int gw = bid_ * 8 + wave, NGW = G_ * 8;
    struct PrepRaw { u32x4 q, k, v; u32x2 cc[3], hh[3], bb; };
    auto prep_load = [&](int row, PrepRaw& R) {
        const bool sample = row >= NPT; const int t = sample ? ((row - NPT) & 4095) : (row & 255); const int n = sample ? 4096 : 256;
        const bf16_t* pr = PROJ + (size_t)row * INW; const int c4 = lane * 4;
        R.q = *(const u32x4*)(pr + 768 + lane * 8);
        R.k = (u32x4){0u, 0u, 0u, 0u}; R.v = (u32x4){0u, 0u, 0u, 0u};
        if (lane < 16) { R.k = *(const u32x4*)(pr + 1280 + lane * 8); if (!sample) R.v = *(const u32x4*)(pr + 1408 + lane * 8); }
#pragma unroll
        for (int j = 0; j < 3; ++j) { const int tt = t + j - 1; R.cc[j] = (u32x2){0u, 0u}; R.hh[j] = (u32x2){0u, 0u};
            if (tt >= 0 && tt < n) { const bf16_t* q = pr + (ptrdiff_t)(j - 1) * INW; R.cc[j] = *(const u32x2*)(q + 256 + c4); R.hh[j] = *(const u32x2*)(q + 512 + c4); } }
        R.bb = *(const u32x2*)(pr + c4);
    };
    PrepRaw Rc;
    if (gw < NTOK) prep_load(gw, Rc);
    for (int row = gw; row < NTOK; row += NGW) {
        PrepRaw Rn = Rc;
        if (row + NGW < NTOK) prep_load(row + NGW, Rn);
        const bool sample = row >= NPT; const int t = sample ? ((row - NPT) & 4095) : (row & 255);
        bf16_t* pr = PROJ + (size_t)row * INW;
        const int d0 = (lane & 7) * 8;
#pragma unroll
        for (int which = 0; which < 2; ++which) {
            const bool act = which == 0 || lane < 16;
            bf16_t* p = pr + (which == 0 ? 768 : 1280) + lane * 8;
            float x[8]; unpack8(which == 0 ? Rc.q : Rc.k, x);
            float ss = 0.f;
#pragma unroll
            for (int e = 0; e < 8; ++e) ss += x[e] * x[e];
            ss += shx(ss, 1, lane); ss += shx(ss, 2, lane); ss += shx(ss, 4, lane);
            const float rs = rsqrtf(ss * (1.f / 64.f) + EPS);
            const float* gp = which == 0 ? qg : kg;
#pragma unroll
            for (int e = 0; e < 8; ++e) x[e] = x[e] * rs * gp[d0 + e];
            if (which == 1 && !sample && act) { float* ok = P.out + OUT_K + ((size_t)((row >> 8) * 2 + l) * 256 + t) * 128 + lane * 8;
                *(f32x4*)ok = (f32x4){x[0], x[1], x[2], x[3]}; *(f32x4*)(ok + 4) = (f32x4){x[4], x[5], x[6], x[7]}; }
            if (sample) {
                const int half = d0 >> 5, part = (d0 >> 4) & 1, i0 = d0 & 15, pos = half ? (t & 63) : (t >> 6);
#pragma unroll
                for (int e = 0; e < 8; ++e) { const float pt = shx(x[e], 2, lane); const float c = tab[2 * (pos * 16 + i0 + e)], s = tab[2 * (pos * 16 + i0 + e) + 1];
                    x[e] = part == 0 ? x[e] * c - pt * s : x[e] * c + pt * s; }
            }
            if (which == 0) {
#pragma unroll
                for (int e = 0; e < 8; ++e) x[e] *= 0.125f * LOG2E;
            }
            if (act) *(u32x4*)p = pack8(x);
        }
        if (!sample && lane < 16) { float x[8]; unpack8(Rc.v, x);
            float* ov = P.out + OUT_V + ((size_t)((row >> 8) * 2 + l) * 256 + t) * 128 + lane * 8;
            *(f32x4*)ov = (f32x4){x[0], x[1], x[2], x[3]}; *(f32x4*)(ov + 4) = (f32x4){x[4], x[5], x[6], x[7]}; }
        {
            const int c4 = lane * 4; float acc[4] = {0.f, 0.f, 0.f, 0.f};
#pragma unroll
            for (int j = 0; j < 3; ++j) { const u32x2 cc = Rc.cc[j], hh = Rc.hh[j];
                const f32x4 w = *(const f32x4*)(cw + j * 256 + c4);
                acc[0] += w[0] * bf_lo(cc.x) * bf_lo(hh.x); acc[1] += w[1] * bf_hi(cc.x) * bf_hi(hh.x); acc[2] += w[2] * bf_lo(cc.y) * bf_lo(hh.y); acc[3] += w[3] * bf_hi(cc.y) * bf_hi(hh.y); }
            const u32x2 bb = Rc.bb;
            u32x2 w; w.x = pk2(acc[0] * bf_lo(bb.x), acc[1] * bf_hi(bb.x)); w.y = pk2(acc[2] * bf_lo(bb.y), acc[3] * bf_hi(bb.y));
            *(u32x2*)(MIX + (size_t)row * D + c4) = w;
        }
        Rc = Rn;
    }
    __syncthreads();
}

template <int J> __device__ __forceinline__ void solve_cols(float (&x)[32], const float* lrow) {
    if constexpr (J < 63) {
        const float xj = __int_as_float(__builtin_amdgcn_update_dpp(0, __float_as_int(x[J >> 1]), (J & 1) ? 0xF5 : 0xA0, 0xf, 0xf, false));
        constexpr int R0 = ((J + 1) / 2) / 4;
#pragma unroll
        for (int r4 = R0; r4 < 8; ++r4) { const f32x4 Lv = *(const f32x4*)(lrow + J * 68 + 4 * r4);
            x[4 * r4 + 0] -= Lv[0] * xj; x[4 * r4 + 1] -= Lv[1] * xj; x[4 * r4 + 2] -= Lv[2] * xj; x[4 * r4 + 3] -= Lv[3] * xj; }
        asm volatile("" : "+v"(x[0]), "+v"(x[1]), "+v"(x[2]), "+v"(x[3]), "+v"(x[4]), "+v"(x[5]), "+v"(x[6]), "+v"(x[7]), "+v"(x[8]), "+v"(x[9]), "+v"(x[10]), "+v"(x[11]), "+v"(x[12]), "+v"(x[13]), "+v"(x[14]), "+v"(x[15]));
        asm volatile("" : "+v"(x[16]), "+v"(x[17]), "+v"(x[18]), "+v"(x[19]), "+v"(x[20]), "+v"(x[21]), "+v"(x[22]), "+v"(x[23]), "+v"(x[24]), "+v"(x[25]), "+v"(x[26]), "+v"(x[27]), "+v"(x[28]), "+v"(x[29]), "+v"(x[30]), "+v"(x[31]));
        solve_cols<J + 1>(x, lrow);
    }
}
constexpr int DN_GROUP = 66560;
__device__ __forceinline__ void dn_chunk_item(const Params& P, int l, int item, unsigned char* lds, int tid_) {
    asm volatile("" : "+v"(tid_));
    const int tid = tid_, dir = tid >> 8, tg = tid & 255, wg = (tid >> 6) & 3, lane = tid & 63, fr = lane & 15, fq = lane >> 4;
    int seq, c, h, n, rowbase, slot;
    if (item < 256) { seq = item >> 4; c = (item >> 2) & 3; h = item & 3; n = 256; rowbase = seq * 256; slot = (seq * 8 + h * 2 + dir) * 4 + c; }
    else { const int it = item - 256; seq = it >> 8; c = (it >> 2) & 63; h = it & 3; n = 4096; rowbase = NPT + seq * 4096; slot = 512 + (seq * 8 + h * 2 + dir) * 64 + c; }
    unsigned char* L = lds + dir * DN_GROUP;
    bf16_t* sq = (bf16_t*)L; bf16_t* sk = sq + 64 * 72; bf16_t* sv = sk + 64 * 72; bf16_t* skT = sv + 64 * 72; bf16_t* sA = skT + 64 * 72;
    float* sL = (float*)(L + 46080); bf16_t* uT = (bf16_t*)(L + 46080); bf16_t* wT = uT + 64 * 72;
    float* sgc = (float*)(L + 46080 + 18432); float* sbeta = sgc + 64; float* sbe = sgc + 128; float* segl = sgc + 192; float* seg = sgc + 256;
    const bf16_t* PROJ = (const bf16_t*)(P.ws + WS_PROJ);
    const int r = tg >> 2, dq = (tg & 3) * 16;
    const int p = dir == 0 ? 64 * c + r : n - 1 - (64 * c + r);
    const bf16_t* pr = PROJ + (size_t)(rowbase + p) * INW;
    u32x4 raw[3][3][2];
#pragma unroll
    for (int mat = 0; mat < 3; ++mat)
#pragma unroll
        for (int j = 0; j < 3; ++j) { const int pp = p + j - 1; const bf16_t* q = pr + (ptrdiff_t)(j - 1) * INW + 1536 + mat * 256 + h * 64 + dq;
            if (pp >= 0 && pp < n) { raw[mat][j][0] = *(const u32x4*)q; raw[mat][j][1] = *(const u32x4*)(q + 8); }
            else { raw[mat][j][0] = (u32x4){0u, 0u, 0u, 0u}; raw[mat][j][1] = (u32x4){0u, 0u, 0u, 0u}; } }
    float beta_r, egl_r;
    {
        const int pg = dir == 0 ? 64 * c + lane : n - 1 - (64 * c + lane);
        const bf16_t* prg = PROJ + (size_t)(rowbase + pg) * INW;
        const float a = bf2f(prg[2560 + dir * 4 + h]), bb = bf2f(prg[2568 + dir * 4 + h]);
        const float Aexp = expf(P.in[18][l * 8 + dir * 4 + h]), dtb = P.in[19][l * 8 + dir * 4 + h];
        const float xx = a + dtb; const float sp = xx > 20.f ? xx : log1pf(expf(xx));
        float gcum = -Aexp * sp;
#pragma unroll
        for (int o = 1; o < 64; o <<= 1) { const float tt = shl_(gcum, (lane - o) & 63, lane); if (lane >= o) gcum += tt; }
        const float gl = shl_(gcum, 63, lane); const float beta = __builtin_amdgcn_rcpf(1.f + __expf(-bb)); const float egl = __expf(gl - gcum);
        if (wg == 0) { sgc[lane] = gcum; sbeta[lane] = beta; const float eg_ = __expf(gcum); sbe[lane] = beta * eg_; segl[lane] = egl; seg[lane] = eg_;
            if (lane == 63) ((float*)(P.ws + WS_DNG))[slot] = __expf(gl); }
        beta_r = shl_(beta, r, lane); egl_r = shl_(egl, r, lane);
    }
    {
#pragma unroll
        for (int mat = 0; mat < 3; ++mat) {
            const int ch0 = mat * 256 + h * 64 + dq;
            const float* cw = P.in[14] + (size_t)l * 3 * 768 + ch0;
            float x[16];
#pragma unroll
            for (int e = 0; e < 16; ++e) x[e] = 0.f;
#pragma unroll
            for (int j = 0; j < 3; ++j) { float v[16]; unpack8(raw[mat][j][0], v); unpack8(raw[mat][j][1], v + 8);
#pragma unroll
                for (int e4 = 0; e4 < 4; ++e4) { const f32x4 w = *(const f32x4*)(cw + j * 768 + 4 * e4);
                    x[4 * e4 + 0] += w[0] * v[4 * e4 + 0]; x[4 * e4 + 1] += w[1] * v[4 * e4 + 1]; x[4 * e4 + 2] += w[2] * v[4 * e4 + 2]; x[4 * e4 + 3] += w[3] * v[4 * e4 + 3]; } }
            float ss = 0.f;
#pragma unroll
            for (int e = 0; e < 16; ++e) { x[e] = x[e] * __builtin_amdgcn_rcpf(1.f + __expf(-x[e])); ss += x[e] * x[e]; }
            if (mat < 2) { ss += shx(ss, 1, lane); ss += shx(ss, 2, lane); const float rs = rsqrtf(ss + EPS) * (mat == 0 ? 0.125f : 1.f);
#pragma unroll
                for (int e = 0; e < 16; ++e) x[e] *= rs; }
            bf16_t* dst = sq + mat * (64 * 72) + r * 72 + dq;
            *(u32x4*)dst = pack8(x); *(u32x4*)(dst + 8) = pack8(x + 8);
            if (mat == 1) {
                float y[16];
#pragma unroll
                for (int e = 0; e < 16; ++e) y[e] = x[e] * beta_r;
                *(u32x4*)(sA + r * 72 + dq) = pack8(y); *(u32x4*)(sA + r * 72 + dq + 8) = pack8(y + 8);
#pragma unroll
                for (int e = 0; e < 16; e += 2) { const unsigned pw = pk2(x[e] * egl_r, x[e + 1] * egl_r); skT[(dq + e) * 72 + r] = (bf16_t)(pw & 0xffffu); skT[(dq + e + 1) * 72 + r] = (bf16_t)(pw >> 16); }
            }
        }
    }
    __syncthreads();
    {
        f32x4 kk[4], qk[4];
        bf16x8 kf0[2], qf[2];
#pragma unroll
        for (int ks = 0; ks < 2; ++ks) { kf0[ks] = *(const bf16x8*)(sk + (16 * wg + fr) * 72 + 32 * ks + 8 * fq); qf[ks] = *(const bf16x8*)(sq + (16 * wg + fr) * 72 + 32 * ks + 8 * fq); }
#pragma unroll
        for (int nb = 0; nb < 4; ++nb) { kk[nb] = (f32x4){0.f, 0.f, 0.f, 0.f}; qk[nb] = (f32x4){0.f, 0.f, 0.f, 0.f};
#pragma unroll
            for (int ks = 0; ks < 2; ++ks) { const bf16x8 kbv = *(const bf16x8*)(sA + (16 * nb + fr) * 72 + 32 * ks + 8 * fq), kv = *(const bf16x8*)(sk + (16 * nb + fr) * 72 + 32 * ks + 8 * fq);
                kk[nb] = mfma16(kf0[ks], kbv, kk[nb]); qk[nb] = mfma16(qf[ks], kv, qk[nb]); } }
        __syncthreads();
#pragma unroll
        for (int nb = 0; nb < 4; ++nb)
#pragma unroll
            for (int jj = 0; jj < 4; ++jj) { const int a = 16 * wg + 4 * fq + jj, bb = 16 * nb + fr;
                const float ga = sgc[a], gb = sgc[bb];
                const float ed = __expf(bb > a ? gb - ga : ga - gb);
                const float decL = bb > a ? ed : 0.f;
                const float decA = a >= bb ? ed : 0.f;
                sL[a * 68 + (bb & 1) * 32 + (bb >> 1)] = kk[nb][jj] * decL;
                sA[a * 72 + bb] = (bf16_t)(pk2(qk[nb][jj] * decA, 0.f) & 0xffffu); }
    }
    __syncthreads();
    {
        const int col = tg >> 1, par = tg & 1;
        const bf16_t* src = (col < 64 ? sv + col : sk + (col - 64)) + par * 72;
        const float* scl = (col < 64 ? sbeta : sbe) + par;
        float x[32];
#pragma unroll
        for (int r = 0; r < 32; ++r) x[r] = bf2f(src[2 * r * 72]) * scl[2 * r];
        solve_cols<0>(x, sL + 32 * par);
        __syncthreads();
        bf16_t* dst = (col < 64 ? uT + col * 72 : wT + (col - 64) * 72) + 32 * par;
        unsigned w[16];
#pragma unroll
        for (int k = 0; k < 32; ++k) {
            const float other = __int_as_float(__builtin_amdgcn_update_dpp(0, __float_as_int(x[k]), 0xB1, 0xf, 0xf, false));
            if (k < 16) { if (par == 0) w[k] = pk2(x[k], other); } else { if (par == 1) w[k - 16] = pk2(other, x[k]); }
        }
#pragma unroll
        for (int e4 = 0; e4 < 4; ++e4) *(u32x4*)(dst + 8 * e4) = (u32x4){w[4 * e4], w[4 * e4 + 1], w[4 * e4 + 2], w[4 * e4 + 3]};
    }
    __syncthreads();
    {
        bf16x8 af[2], kf[2];
#pragma unroll
        for (int ks = 0; ks < 2; ++ks) { af[ks] = *(const bf16x8*)(sA + (16 * wg + fr) * 72 + 32 * ks + 8 * fq); kf[ks] = *(const bf16x8*)(skT + (16 * wg + fr) * 72 + 32 * ks + 8 * fq); }
        bf16_t* gM = (bf16_t*)(P.ws + WS_DN) + (size_t)slot * 4096; bf16_t* gB = (bf16_t*)(P.ws + WS_DN + DN_MAT) + (size_t)slot * 4096; bf16_t* gQ = (bf16_t*)(P.ws + WS_DN + 2 * DN_MAT) + (size_t)slot * 4096;
        const int irow = 16 * wg + fr;
        const int pi = dir == 0 ? 64 * c + irow : n - 1 - (64 * c + irow);
        bf16_t* gO = (bf16_t*)(P.ws + WS_OFB) + ((size_t)dir * NTOK + rowbase + pi) * 256 + h * 64;
        const float eg_i = seg[irow];
#pragma unroll
        for (int nb = 0; nb < 4; ++nb) {
            f32x4 aw = (f32x4){0.f, 0.f, 0.f, 0.f}, au = aw, mx = aw, bx = aw;
#pragma unroll
            for (int ks = 0; ks < 2; ++ks) { const bf16x8 wf = *(const bf16x8*)(wT + (16 * nb + fr) * 72 + 32 * ks + 8 * fq), uf = *(const bf16x8*)(uT + (16 * nb + fr) * 72 + 32 * ks + 8 * fq);
                aw = mfma16(wf, af[ks], aw); au = mfma16(uf, af[ks], au); mx = mfma16(wf, kf[ks], mx); bx = mfma16(kf[ks], uf, bx); }
            const int cc = 16 * nb + 4 * fq;
            u32x2 w;
            const int fo = (((wg * 2 + (cc >> 5)) * 64 + ((cc & 31) >> 3) * 16 + fr) * 8 + (cc & 7));
            w.x = pk2(-mx[0], -mx[1]); w.y = pk2(-mx[2], -mx[3]); *(u32x2*)(gM + fo) = w;
            w.x = pk2(bx[0], bx[1]); w.y = pk2(bx[2], bx[3]); *(u32x2*)(gB + ((nb * 4 + wg) * 64 + fq * 16 + fr) * 4) = w;
            const u32x2 qq = *(const u32x2*)(sq + irow * 72 + cc);
            w.x = pk2(bf_lo(qq.x) * eg_i - aw[0], bf_hi(qq.x) * eg_i - aw[1]); w.y = pk2(bf_lo(qq.y) * eg_i - aw[2], bf_hi(qq.y) * eg_i - aw[3]); *(u32x2*)(gQ + fo) = w;
            w.x = pk2(au[0], au[1]); w.y = pk2(au[2], au[3]); *(u32x2*)(gO + cc) = w;
        }
    }
    lds_barrier();
}

template <int NT = 2, bool DRY = false> __device__ __forceinline__ void dn_scan_chain(const Params& P, int l, int chain, int vhalf, unsigned char* lds, int tid_) {
    const int tid = tid_, w = tid >> 6, lane = tid & 63, fr = lane & 15, fq = lane >> 4, rb = w >> 1, cb0 = NT == 2 ? (w & 1) * 2 : vhalf * 2 + (w & 1);
    int seq, h, dir, n, nc, rowbase, slot0; bool sample;
    if (chain < 128) { seq = chain >> 3; h = (chain >> 1) & 3; dir = chain & 1; n = 256; nc = 4; rowbase = seq * 256; slot0 = chain * 4; sample = false; }
    else { const int cc = chain - 128; seq = cc >> 3; h = (cc >> 1) & 3; dir = cc & 1; n = 4096; nc = 64; rowbase = NPT + seq * 4096; slot0 = 512 + cc * 64; sample = true; }
    bf16_t* ST = (bf16_t*)lds;
    const size_t sidx = ((size_t)((seq * 2 + l) * 2 + dir) * 4 + h) * 4096;
    f32x4 S[NT];
#pragma unroll
    for (int t = 0; t < NT; ++t) { const int v = 16 * (cb0 + t) + fr;
#pragma unroll
        for (int jj = 0; jj < 4; ++jj) S[t][jj] = sample ? P.in[4][sidx + (16 * rb + 4 * fq + jj) * 64 + v] : 0.f;
        u32x2 wv; wv.x = pk2(S[t][0], S[t][1]); wv.y = pk2(S[t][2], S[t][3]); *(u32x2*)(ST + v * 72 + 16 * rb + 4 * fq) = wv; }
    __syncthreads();
    const bf16_t* gMb = (const bf16_t*)(P.ws + WS_DN); const bf16_t* gBb = (const bf16_t*)(P.ws + WS_DN + DN_MAT); const bf16_t* gQb = (const bf16_t*)(P.ws + WS_DN + 2 * DN_MAT);
    const float* gG = (const float*)(P.ws + WS_DNG);
    bf16_t* OFB = (bf16_t*)(P.ws + WS_OFB) + (size_t)dir * NTOK * 256;
    auto load_step = [&](int c, bf16x8 (&M_)[2], bf16x8 (&Q_)[2], float& eg_, u32x2 (&bt_)[NT], u32x2 (&o0_)[NT]) {
        const int slot = slot0 + c;
        const bf16_t* gM = gMb + (size_t)slot * 4096; const bf16_t* gB = gBb + (size_t)slot * 4096; const bf16_t* gQ = gQb + (size_t)slot * 4096;
#pragma unroll
        for (int ks = 0; ks < 2; ++ks) { M_[ks] = *(const bf16x8*)(gM + ((rb * 2 + ks) * 64 + lane) * 8); Q_[ks] = *(const bf16x8*)(gQ + ((rb * 2 + ks) * 64 + lane) * 8); }
        eg_ = gG[slot];
        const int il = 16 * rb + fr; const int pi = dir == 0 ? 64 * c + il : n - 1 - (64 * c + il);
        const bf16_t* orow = OFB + (size_t)(rowbase + pi) * 256 + h * 64;
#pragma unroll
        for (int t = 0; t < NT; ++t) { const int cb = cb0 + t; bt_[t] = *(const u32x2*)(gB + ((cb * 4 + rb) * 64 + lane) * 4); o0_[t] = *(const u32x2*)(orow + 16 * cb + 4 * fq); }
    };
    bf16x8 Mr[4][2], Qr[4][2]; float er[4]; u32x2 br[4][NT], orr[4][NT];
#pragma unroll
    for (int k = 0; k < 4; ++k) load_step(k, Mr[k], Qr[k], er[k], br[k], orr[k]);
    for (int c0 = 0; c0 < nc; c0 += 4) {
#pragma unroll
        for (int k = 0; k < 4; ++k) {
            const int c = c0 + k, cur = k & 1;
            const int il = 16 * rb + fr; const int pi = dir == 0 ? 64 * c + il : n - 1 - (64 * c + il);
            bf16_t* orow = OFB + (size_t)(rowbase + pi) * 256 + h * 64;
            const float egc = er[k];
#pragma unroll
            for (int t = 0; t < NT; ++t) { const int cb = cb0 + t;
                const u32x2 bt = br[k][t], o0 = orr[k][t];
                bf16x8 Sf[2];
#pragma unroll
                for (int ks = 0; ks < 2; ++ks) Sf[ks] = *(const bf16x8*)(ST + cur * 64 * 72 + (16 * cb + fr) * 72 + 32 * ks + 8 * fq);
                f32x4 o = (f32x4){bf_lo(o0.x), bf_hi(o0.x), bf_lo(o0.y), bf_hi(o0.y)};
                o = mfma16(Sf[0], Qr[k][0], o); o = mfma16(Sf[1], Qr[k][1], o);
                u32x2 wv; wv.x = pk2(o[0], o[1]); wv.y = pk2(o[2], o[3]); if (!DRY || o[0] == 1234.5f) *(u32x2*)(orow + 16 * cb + 4 * fq) = wv;
                f32x4 s = S[t] * egc + (f32x4){bf_lo(bt.x), bf_hi(bt.x), bf_lo(bt.y), bf_hi(bt.y)};
                s = mfma16(Mr[k][0], Sf[0], s); s = mfma16(Mr[k][1], Sf[1], s);
                S[t] = s;
                wv.x = pk2(s[0], s[1]); wv.y = pk2(s[2], s[3]); *(u32x2*)(ST + (cur ^ 1) * 64 * 72 + (16 * cb + fr) * 72 + 16 * rb + 4 * fq) = wv;
            }
            if (c + 4 < nc) load_step(c + 4, Mr[k], Qr[k], er[k], br[k], orr[k]);
            lds_barrier();
        }
    }
    if (!sample && !DRY) {
#pragma unroll
        for (int t = 0; t < NT; ++t) { const int v = 16 * (cb0 + t) + fr;
#pragma unroll
            for (int jj = 0; jj < 4; ++jj) P.out[OUT_S + sidx + (16 * rb + 4 * fq + jj) * 64 + v] = S[t][jj]; }
    }
    __syncthreads();
}

__device__ __forceinline__ void attn_unit(const Params& P, int l, int unit, unsigned char* lds, int tid_) {
    const int tid = tid_, w = tid >> 6, lane = tid & 63, fr = lane & 15, fq = lane >> 4;
    bool sample; int seq, kvh, qb;
    if (unit < 512) { sample = true; seq = unit >> 7; kvh = (unit >> 6) & 1; qb = unit & 63; }
    else { const int u2 = unit - 512; sample = false; seq = u2 >> 3; kvh = (u2 >> 2) & 1; qb = u2 & 3; }
    const int g = w >> 1, hq = kvh * 4 + g, q0 = qb * 64, qoff = (w & 1) * 32;
    const int rowbase = sample ? NPT + seq * 4096 : seq * 256, n = sample ? 4096 : 256;
    const bf16_t* PROJ = (const bf16_t*)(P.ws + WS_PROJ);
    bf16_t* Ks = (bf16_t*)lds;
    bf16_t* VT = Ks + 2 * 64 * 72;
    bf16x8 Qf[2][2];
#pragma unroll
    for (int qk = 0; qk < 2; ++qk)
#pragma unroll
        for (int ks = 0; ks < 2; ++ks) Qf[qk][ks] = *(const bf16x8*)(PROJ + (size_t)(rowbase + q0 + qoff + 16 * qk + fr) * INW + 768 + hq * 64 + 32 * ks + 8 * fq);
    const float sinkv = P.in[17][l * 8 + hq] * LOG2E;
    float mrun[2] = {sinkv, sinkv}, lsum[2] = {fq == 0 ? 1.f : 0.f, fq == 0 ? 1.f : 0.f};
    f32x4 O[2][4];
#pragma unroll
    for (int a = 0; a < 2; ++a)
#pragma unroll
        for (int b = 0; b < 4; ++b) O[a][b] = (f32x4){0.f, 0.f, 0.f, 0.f};
    int jlo = 0, jhi = 0, ntile;
    if (sample) { jlo = q0 >= 128 ? 0 : (128 - q0) / 64; jhi = (n + 64 - q0) / 64; if (jhi > 4) jhi = 4; ntile = 8 + (jhi - jlo + 1); } else ntile = 4;
    const int key = tid >> 3, dch = (tid & 7) * 8;
    auto load_tile = [&](int t, u32x4& kreg, u32x4& vreg) {
        if (sample && t < 8) {
            const size_t ci = ((size_t)(seq * 512 + 64 * t + key)) * 128 + kvh * 64 + dch;
            kreg = *(const u32x4*)((const bf16_t*)(P.ws + WS_CK) + ci); vreg = *(const u32x4*)((const bf16_t*)(P.ws + WS_CV) + ci);
        } else {
            const int ts = sample ? q0 - 128 + 64 * (jlo + t - 8) : 64 * t;
            const bf16_t* pr = PROJ + (size_t)(rowbase + ts + key) * INW + kvh * 64 + dch;
            kreg = *(const u32x4*)(pr + 1280); vreg = *(const u32x4*)(pr + 1408);
        }
    };
    auto store_tile = [&](int buf, const u32x4& kreg, const u32x4& vreg) {
        *(u32x4*)(Ks + buf * 64 * 72 + key * 72 + dch) = kreg;
        *(u32x4*)(VT + buf * 64 * 72 + key * 72 + dch) = vreg;
    };
    u32x4 kr[3], vr[3];
    load_tile(0, kr[0], vr[0]); store_tile(0, kr[0], vr[0]);
#pragma unroll
    for (int k = 0; k < 3; ++k) if (k + 1 < ntile) load_tile(k + 1, kr[k], vr[k]);
    lds_barrier();
    for (int t0 = 0; t0 < ntile; t0 += 3) {
#pragma unroll
        for (int k = 0; k < 3; ++k) {
            const int t = t0 + k;
            if (t < ntile) {
        const int cur = t & 1;
        const bf16_t* Kc = Ks + cur * 64 * 72; const bf16_t* Vc = VT + cur * 64 * 72;
        const int jw = jlo + t - 8;
        const bool masked = sample && t >= 8 && (jw == 0 || jw == 4);
        const int ts = masked ? q0 - 128 + 64 * jw : 0;
        f32x4 s[2][4];
#pragma unroll
        for (int kb = 0; kb < 4; ++kb) {
            bf16x8 kf[2];
#pragma unroll
            for (int ks = 0; ks < 2; ++ks) kf[ks] = *(const bf16x8*)(Kc + (16 * kb + fr) * 72 + 32 * ks + 8 * fq);
#pragma unroll
            for (int qk = 0; qk < 2; ++qk) { f32x4 a = (f32x4){0.f, 0.f, 0.f, 0.f}; a = mfma16(kf[0], Qf[qk][0], a); a = mfma16(kf[1], Qf[qk][1], a); s[qk][kb] = a; }
        }
        bf16x8 pf[2][2];
#pragma unroll
        for (int qk = 0; qk < 2; ++qk) {
            if (masked) { const int qp = q0 + qoff + 16 * qk + fr;
#pragma unroll
                for (int kb = 0; kb < 4; ++kb)
#pragma unroll
                    for (int jj = 0; jj < 4; ++jj) { const int kp = ts + 16 * kb + 4 * fq + jj; const int df = qp - kp; if (df > 128 || df < -128) s[qk][kb][jj] = -1e30f; } }
            float mx = s[qk][0][0];
#pragma unroll
            for (int kb = 0; kb < 4; ++kb)
#pragma unroll
                for (int jj = 0; jj < 4; ++jj) mx = fmaxf(mx, s[qk][kb][jj]);
            mx = fmaxf(mx, shx(mx, 16, lane)); mx = fmaxf(mx, shx(mx, 32, lane));
            const float mnew = fmaxf(mrun[qk], mx); const float alpha = __builtin_amdgcn_exp2f(mrun[qk] - mnew); mrun[qk] = mnew;
            float ps = 0.f;
#pragma unroll
            for (int kb = 0; kb < 4; ++kb)
#pragma unroll
                for (int jj = 0; jj < 4; ++jj) { const float p = __builtin_amdgcn_exp2f(s[qk][kb][jj] - mnew); s[qk][kb][jj] = p; ps += p; }
            lsum[qk] = lsum[qk] * alpha + ps;
            if (__builtin_amdgcn_ballot_w64(alpha != 1.f) != 0ull) {
#pragma unroll
                for (int db = 0; db < 4; ++db) O[qk][db] = O[qk][db] * alpha; }
#pragma unroll
            for (int m2 = 0; m2 < 2; ++m2) { u32x4 pw; pw.x = pk2(s[qk][2 * m2][0], s[qk][2 * m2][1]); pw.y = pk2(s[qk][2 * m2][2], s[qk][2 * m2][3]);
                pw.z = pk2(s[qk][2 * m2 + 1][0], s[qk][2 * m2 + 1][1]); pw.w = pk2(s[qk][2 * m2 + 1][2], s[qk][2 * m2 + 1][3]); pf[qk][m2] = as_bf8(pw); }
        }
#pragma unroll
        for (int db = 0; db < 4; ++db)
#pragma unroll
            for (int m2 = 0; m2 < 2; ++m2) {
                const bf16_t* vp = Vc + (32 * m2 + 4 * fq + (fr >> 2)) * 72 + 16 * db + 4 * (fr & 3);
                const v4i16_t t0 = __builtin_amdgcn_ds_read_tr16_b64_v4i16((LAS v4i16_t*)vp), t1 = __builtin_amdgcn_ds_read_tr16_b64_v4i16((LAS v4i16_t*)(vp + 16 * 72));
                const bf16x8 vf = __builtin_shufflevector(__builtin_bit_cast(bf16x4_t, t0), __builtin_bit_cast(bf16x4_t, t1), 0, 1, 2, 3, 4, 5, 6, 7);
                O[0][db] = mfma16(vf, pf[0][m2], O[0][db]); O[1][db] = mfma16(vf, pf[1][m2], O[1][db]); }
        if (t + 1 < ntile) store_tile(cur ^ 1, kr[k], vr[k]);
        if (t + 4 < ntile) load_tile(t + 4, kr[k], vr[k]);
        lds_barrier();
            }
        }
    }
    bf16_t* MIX = (bf16_t*)(P.ws + WS_ABUF);
#pragma unroll
    for (int qk = 0; qk < 2; ++qk) { float lt = lsum[qk]; lt += shx(lt, 16, lane); lt += shx(lt, 32, lane); const float inv = __builtin_amdgcn_rcpf(lt);
        bf16_t* orow = MIX + (size_t)(rowbase + q0 + qoff + 16 * qk + fr) * D + 256 + hq * 64;
#pragma unroll
        for (int db = 0; db < 4; ++db) { const f32x4 o = O[qk][db] * inv; u32x2 wv; wv.x = pk2(o[0], o[1]); wv.y = pk2(o[2], o[3]); *(u32x2*)(orow + 16 * db + 4 * fq) = wv; } }
}

__device__ __forceinline__ void convert_gu_dn(const Params& P, int l, unsigned char* lds, int tid_, int gw, int NGW) {
    const int lane = tid_ & 63, wave = tid_ >> 6;
    float* scr = (float*)(lds + wave * 8448);
    constexpr int I_G = 16 * 88, I_D = 44 * 32;
    for (int it = gw; it < 2 * I_G + I_D; it += NGW) {
        int r = it;
        if (r < I_G) { transpose_item<1>(P.in[21] + (size_t)l * 1024 * FF, 1024, FF, 88, (bf16_t*)(P.ws + WS_WGU), scr, r, lane); continue; } r -= I_G;
        if (r < I_G) { transpose_item<2>(P.in[22] + (size_t)l * 1024 * FF, 1024, FF, 88, (bf16_t*)(P.ws + WS_WGU), scr, r, lane); continue; } r -= I_G;
        transpose_item<0>(P.in[23] + (size_t)l * FF * 1024, FF, 1024, 32, (bf16_t*)(P.ws + WS_WDN), scr, r, lane);
    }
}

__device__ __forceinline__ void convert_in_out_l1(const Params& P, unsigned char* lds, int tid_, int gw, int NGW) {
    const int lane = tid_ & 63, wave = tid_ >> 6;
    float* scr = (float*)(lds + wave * 8448);
    constexpr int I_IN = 16 * 88;
    for (int it = gw; it < I_IN; it += NGW) transpose_item<0>(P.in[7] + (size_t)1024 * INW, 1024, INW, 88, (bf16_t*)(P.ws + WS_WIN) + (size_t)INP * 1024, scr, it, lane);
}

__device__ __forceinline__ void phase_e(const Params& P, int l, unsigned char* lds, int tid_, int bid_, int G_) {
    const int tid = tid_, lane = tid & 63, wave = tid >> 6, G = G_;
    const int gw = bid_ * 8 + wave, NGW = G * 8;
    float* scr = (float*)(lds + wave * 8448);
    constexpr int I_O = 16 * 32;
    for (int it = gw; it < I_O; it += NGW) transpose_item<0>(P.in[8] + (size_t)l * 1024 * 1024, 1024, 1024, 32, (bf16_t*)(P.ws + WS_WOUT), scr, it, lane);
    const bf16_t* PROJ = (const bf16_t*)(P.ws + WS_PROJ); const bf16_t* OF = (const bf16_t*)(P.ws + WS_OFB); const bf16_t* OB = OF + (size_t)NTOK * 256;
    bf16_t* MIX = (bf16_t*)(P.ws + WS_ABUF);
    const float* ng = P.in[20] + l * 64;
    const int c4 = lane * 4;
    u32x2 a = (u32x2){0u, 0u}, b = a, z = a, a1 = a, b1 = a, z1 = a;
    if (gw < NTOK) { a = *(const u32x2*)(OF + (size_t)gw * 256 + c4); b = *(const u32x2*)(OB + (size_t)gw * 256 + c4); z = *(const u32x2*)(PROJ + (size_t)gw * INW + 2304 + c4); }
    if (gw + NGW < NTOK) { const int r1 = gw + NGW; a1 = *(const u32x2*)(OF + (size_t)r1 * 256 + c4); b1 = *(const u32x2*)(OB + (size_t)r1 * 256 + c4); z1 = *(const u32x2*)(PROJ + (size_t)r1 * INW + 2304 + c4); }
    for (int row = gw; row < NTOK; row += NGW) {
        u32x2 an = a1, bn = b1, zn = z1; const int nr = row + 2 * NGW;
        if (nr < NTOK) { an = *(const u32x2*)(OF + (size_t)nr * 256 + c4); bn = *(const u32x2*)(OB + (size_t)nr * 256 + c4); zn = *(const u32x2*)(PROJ + (size_t)nr * INW + 2304 + c4); }
        float o[4] = {bf_lo(a.x) + bf_lo(b.x), bf_hi(a.x) + bf_hi(b.x), bf_lo(a.y) + bf_lo(b.y), bf_hi(a.y) + bf_hi(b.y)};
        float ss = o[0] * o[0] + o[1] * o[1] + o[2] * o[2] + o[3] * o[3];
        ss += shx(ss, 1, lane); ss += shx(ss, 2, lane); ss += shx(ss, 4, lane); ss += shx(ss, 8, lane);
        const float rs = rsqrtf(ss * (1.f / 64.f) + EPS);
        const f32x4 gg = *(const f32x4*)(ng + (c4 & 63));
        const float zz[4] = {bf_lo(z.x), bf_hi(z.x), bf_lo(z.y), bf_hi(z.y)};
        float y[4];
#pragma unroll
        for (int k = 0; k < 4; ++k) y[k] = o[k] * rs * gg[k] * siluf(zz[k]);
        u32x2 wv; wv.x = pk2(y[0], y[1]); wv.y = pk2(y[2], y[3]);
        *(u32x2*)(MIX + (size_t)row * D + 768 + c4) = wv;
        a = a1; b = b1; z = z1; a1 = an; b1 = bn; z1 = zn;
    }
}


#define XB_TMO      128
#define XB_XCNT(j)  (256  + 64 * (j))
#define XB_XSUB(j)  (1280 + 64 * (j))
#define XB_XGEN(j)  (2304 + 64 * (j))
#define XB_TOP      3328
#define XB_TOPGEN   3392
#define XCD_BAR_WORDS 3456
#define XB_SPIN_CAP (1u << 18)
__device__ __forceinline__ unsigned xb_ld(unsigned* p)              { return __hip_atomic_load(p, __ATOMIC_RELAXED, __HIP_MEMORY_SCOPE_AGENT); }
__device__ __forceinline__ unsigned xb_add(unsigned* p, unsigned v) { return __hip_atomic_fetch_add(p, v, __ATOMIC_RELAXED, __HIP_MEMORY_SCOPE_AGENT); }
__device__ __forceinline__ unsigned xb_xcc_id() { return (unsigned)__builtin_amdgcn_s_getreg((3 << 11) | 20) & 0xFu; }
#define XB_SPIN(cond, bar) do { unsigned _sp = 0; while (cond) { __builtin_amdgcn_s_sleep(1); \
    if ((++_sp & 255u) == 0u) { if (xb_ld(&(bar)[XB_TMO])) break; if (_sp > XB_SPIN_CAP) { atomicAdd(&(bar)[XB_TMO], 1u); break; } } } } while (0)
__device__ __forceinline__ void xcd_barrier_complete(unsigned* bar, unsigned x, unsigned G, unsigned& nloc, unsigned& nx) {
    unsigned sum, cnt, mine, sp = 0u;
    for (;;) {
        sum = 0u; cnt = 0u; mine = 0u;
#pragma unroll
        for (unsigned j = 0; j < 16; ++j) { const unsigned c = xb_ld(&bar[XB_XCNT(j)]); sum += c; cnt += (c > 0u) ? 1u : 0u; mine = (j == x) ? c : mine; }
        if (sum == G) break;
        __builtin_amdgcn_s_sleep(1);
        if ((++sp & 255u) == 0u) { if (xb_ld(&bar[XB_TMO])) break; if (sp > XB_SPIN_CAP) { atomicAdd(&bar[XB_TMO], 1u); break; } }
    }
    nloc = mine > 0u ? mine : 1u; nx = cnt > 0u ? cnt : 1u;
}
__device__ __forceinline__ void xcd_barrier(unsigned* bar, volatile LAS unsigned* st, int tid_, unsigned G) {
    asm volatile("s_waitcnt vmcnt(0)" ::: "memory");
    __syncthreads();
    if (tid_ == 0) {
        const unsigned x = xb_xcc_id();
        __builtin_amdgcn_s_waitcnt(0);
        unsigned nloc = st[0], nx = st[1];
        if (nloc == 0u) { xcd_barrier_complete(bar, x, G, nloc, nx); st[0] = nloc; st[1] = nx; }
        const unsigned old = xb_add(&bar[XB_XSUB(x)], 1u);
        const unsigned gen = old / nloc;
        if (old + 1u == (gen + 1u) * nloc) {
            __builtin_amdgcn_fence(__ATOMIC_RELEASE, "agent");
            asm volatile("s_waitcnt vmcnt(0)" ::: "memory");
            const unsigned og = xb_add(&bar[XB_TOP], 1u);
            const unsigned tg = og / nx;
            if (og + 1u == (tg + 1u) * nx) xb_add(&bar[XB_TOPGEN], 1u);
            else XB_SPIN(xb_ld(&bar[XB_TOPGEN]) == tg, bar);
            __builtin_amdgcn_fence(__ATOMIC_ACQUIRE, "agent");
            xb_add(&bar[XB_XGEN(x)], 1u);
            asm volatile("s_waitcnt vmcnt(0)" ::: "memory");
        } else {
            XB_SPIN(xb_ld(&bar[XB_XGEN(x)]) == gen, bar);
            __builtin_amdgcn_fence(__ATOMIC_ACQUIRE, "agent");
            asm volatile("s_waitcnt vmcnt(0)" ::: "memory");
        }
    }
    __syncthreads();
}

__global__ void __launch_bounds__(512, 2) trunk_fwd(Params P0) {
    extern __shared__ __attribute__((aligned(16))) unsigned char lds[];
    cg::grid_group grid = cg::this_grid();
    const int G0 = gridDim.x, b0 = blockIdx.x;
    const int wave0 = __builtin_amdgcn_readfirstlane(threadIdx.x >> 6);
    const int ph_lo = P0.ph_lo, ph_hi = P0.ph_hi;
    {
        unsigned long long* tb = (unsigned long long*)(lds + PTAB_OFF);
        if (threadIdx.x == 0) {
#pragma unroll
            for (int i = 0; i < 24; ++i) tb[i] = (unsigned long long)P0.in[i];
            tb[24] = (unsigned long long)P0.out; tb[25] = (unsigned long long)P0.ws;
            tb[28] = 0ull;
        }
        if (threadIdx.x == 0) (void)xb_add(&((unsigned*)(P0.ws + WS_BAR))[XB_XCNT(xb_xcc_id())], 1u);
        __syncthreads();
    }
    for (int ph = ph_lo; ph < ph_hi; ++ph) {
        int tid, G = G0, b = b0;
        asm volatile("v_mbcnt_lo_u32_b32 %0, -1, 0\n\tv_mbcnt_hi_u32_b32 %0, -1, %0" : "=v"(tid) : : "memory"); tid += wave0 * 64;
        asm volatile("" : "+s"(G), "+s"(b));
        if (ph > ph_lo) {
            unsigned char* wsb; { unsigned tboff = PTAB_OFF; asm volatile("" : "+v"(tboff)); wsb = (unsigned char*)(__attribute__((address_space(1))) unsigned char*)uni64(((const unsigned long long*)(lds + tboff))[25]); }
            xcd_barrier((unsigned*)(wsb + WS_BAR), (volatile LAS unsigned*)(lds + PTAB_OFF + 224), tid, (unsigned)G);
            if (ph_hi > 1000) grid.sync();
        }
        Params P;
        {   unsigned tboff = PTAB_OFF; asm volatile("" : "+v"(tboff));
            const unsigned long long* tb = (const unsigned long long*)(lds + tboff);
#pragma unroll
            for (int i = 0; i < 24; ++i) P.in[i] = (const float*)(const __attribute__((address_space(1))) float*)uni64(tb[i]);
            P.out = (float*)(__attribute__((address_space(1))) float*)uni64(tb[24]); P.ws = (unsigned char*)(__attribute__((address_space(1))) unsigned char*)uni64(tb[25]); P.ph_lo = 0; P.ph_hi = 0; }
        float* X = P.out;
        const float* modw = (const float*)(P.ws + WS_MOD);
        bf16_t* ABUF = (bf16_t*)(P.ws + WS_ABUF);
        if (ph == 0) { phase0(P, lds, tid, b, G); continue; }
        const int l = (ph - 1) / 9, sub = (ph - 1) % 9;
        const float* modl = modw + (size_t)l * 5 * 6144;
        const float* xa = l == 0 ? P.in[0] : X; const float* xb = l == 0 ? P.in[1] : X + (size_t)NPT * D;
        if (sub == 1 || sub == 5 || sub == 7 || sub == 8) {
            pg8::Gemm g; EpiAny E;
            const bool s1 = sub == 1, s5 = sub == 5, s7 = sub == 7, s8 = sub == 8;
            unsigned long long a_off = s8 ? WS_PROJ : WS_ABUF;
            unsigned long long b_off = s1 ? WS_WIN + (unsigned long long)l * INP * 1024 * 2 : (s5 ? WS_WOUT : (s7 ? WS_WGU : WS_WDN));
            int nn = s1 ? INP : (s7 ? FF2 : D), kk = s8 ? FF : D, mode = s1 ? 0 : (s7 ? 2 : 1), goff = s8 ? 5120 : 2048;
            const float* exa = s5 ? xa : X; const float* exb = s5 ? xb : X + (size_t)NPT * D;
            asm volatile("" : "+s"(a_off), "+s"(b_off), "+s"(nn), "+s"(kk), "+s"(mode), "+s"(goff), "+s"(exa), "+s"(exb));
            g.M = NTOK; g.A = (const bf16_t*)(P.ws + a_off); g.Bt = (const bf16_t*)(P.ws + b_off); g.N = nn; g.K = kk;
            E.O = (bf16_t*)(P.ws + WS_PROJ); E.xa = exa; E.xb = exb; E.modl = modl; E.out = X; E.goff = goff; E.mode = mode; E.perm = mode != 1;
            pg8::StaticOrder S; S.init(NTOK, g.N, G, b);
            pg8::gemm_phase<EpiAny, pg8::StaticOrder, true, true>((LAS unsigned char*)lds, g, S, E, tid);
            if (s5) {
                const int two = 320 - G;
                const int first = (two > 0 && two < G) ? two : 0, nh = G - first;
                if (b >= first) { __syncthreads(); convert_gu_dn(P, l, lds, tid, (b - first) * 8 + (tid >> 6), nh * 8); }
            }
            if (s8 && l == 0) {
                const int two = 320 - G; const int first = (two > 0 && two < G) ? two : 0, nh = G - first;
                if (b >= first) { __syncthreads(); convert_in_out_l1(P, lds, tid, (b - first) * 8 + (tid >> 6), nh * 8); }
            }
            continue;
        }
        switch (sub) {
        case 0: norm_phase(xa, xb, P.in[11] + l * D, modl, 0, 1024, ABUF, tid, b, G);
            break;
        case 2: { prep_rows(P, l, lds, tid, b, G); for (int it = b; it < 1280; it += G) dn_chunk_item(P, l, it, lds, tid);
        } break;
        case 3: {
            const int nA = G > 128 ? 64 : 0;
            if (b < nA) { dn_scan_chain<1>(P, l, 128 + (b >> 1), b & 1, lds, tid); }
            else { const int bb = b - nA, GB = G - nA;
                if (nA == 0) for (int ch = bb; ch < 32; ch += GB) dn_scan_chain<2>(P, l, 128 + ch, 0, lds, tid);
                for (int ch = bb; ch < 128; ch += GB) dn_scan_chain<2>(P, l, ch, 0, lds, tid);
            }
            {
                unsigned* ctr = (unsigned*)(P.ws + WS_BAR) + 3584 + 64 * l;
                volatile LAS unsigned* wsl = (volatile LAS unsigned*)(lds + PTAB_OFF + 232);
                for (;;) {
                    __syncthreads();
                    if (tid == 0) wsl[0] = xb_add(ctr, 1u);
                    __syncthreads();
                    const unsigned u = wsl[0];
                    if (u >= 640u) break;
                    attn_unit(P, l, (int)u, lds, tid);
                }
            }
        } break;
        case 4: phase_e(P, l, lds, tid, b, G);
            break;
        case 6: norm_phase(X, X + (size_t)NPT * D, P.in[12] + l * D, modl, 3072, 4096, ABUF, tid, b, G); break;
        default: break;
        }
    }
}

extern "C" void kernel_launch(void* const* d_in, const int* in_sizes, int n_in, void* d_out, int out_size, void* d_ws, size_t ws_size, hipStream_t stream) {
    static int grid = 0;
    if (grid == 0) {
        if (n_in != 24 || ws_size < WS_END) { fprintf(stderr, "kernel_launch: unexpected n_in %d / ws %zu (need %zu)\n", n_in, ws_size, (size_t)WS_END); grid = -1; return; }
        int dev = 0, cus = 0, per_cu = 0;
        hipGetDevice(&dev); hipDeviceGetAttribute(&cus, hipDeviceAttributeMultiprocessorCount, dev);
        if (hipFuncSetAttribute((const void*)trunk_fwd, hipFuncAttributeMaxDynamicSharedMemorySize, LDS_BYTES) != hipSuccess) { fprintf(stderr, "hipFuncSetAttribute failed\n"); grid = -1; return; }
        if (hipOccupancyMaxActiveBlocksPerMultiprocessor(&per_cu, (const void*)trunk_fwd, 512, LDS_BYTES) != hipSuccess || per_cu < 1) { fprintf(stderr, "occupancy query failed (%d)\n", per_cu); per_cu = 1; }
        (void)hipGetLastError();
        grid = cus * (per_cu > 1 ? 1 : per_cu);
    }
    if (grid < 0) return;
    Params p{};
    for (int i = 0; i < 24; ++i) p.in[i] = (const float*)d_in[i];
    p.out = (float*)d_out; p.ws = (unsigned char*)d_ws; p.ph_lo = 0; p.ph_hi = 19;
    if (hipMemsetAsync((unsigned char*)d_ws + WS_BAR, 0, 16384, stream) != hipSuccess) { fprintf(stderr, "hipMemsetAsync of the barrier words failed\n"); return; }
    void* args[] = {&p};
    hipError_t e = hipLaunchCooperativeKernel((const void*)trunk_fwd, dim3(grid), dim3(512), args, LDS_BYTES, stream);
    if (e != hipSuccess) fprintf(stderr, "cooperative launch failed: %s (grid %d)\n", hipGetErrorString(e), grid);
}
```
